# Optimizing an MI355X kernel written in HIP

```python
import math
import jax
import jax.numpy as jnp
from jax import lax
import numpy as np

D_MODEL = 1024
BATCH = 8
SEQ = 4096
DEPTH = 2

GRID_W = 64
CTX_LEN = 256
N_MIXERS = 2
NORM_EPS = 1e-6

MLA_HEADS = 16
Q_LORA = 384
KV_LORA = 256
QK_NOPE = 64
QK_ROPE = 32
V_DIM = 64
ROPE_BASE = 10000.0
Q_BLOCK = 128

HY_ORDER = 2
HY_EMB = 33
HY_BANDS = (HY_EMB - 1) // 2
HY_FFN = 64
HY_SHORT = 3
HY_TARGET = 1e-2
HY_FAST_PCT = 0.3
HY_SLOW_PCT = 1.5

PEER_HEADS = 8
PEER_NK = 128
PEER_EXPERTS = PEER_NK * PEER_NK
PEER_DK = 256
PEER_TOPK = 16
PEER_CHUNK = 512

kernel_name = "hybrid_mla_hyena_peer_diffusion_block"


def rmsnorm(x, g):
    xf = x.astype(jnp.float32)
    y = xf * lax.rsqrt(jnp.mean(xf * xf, axis=-1, keepdims=True) + NORM_EPS)
    return y.astype(x.dtype) * g


def modulate(h, shift, scale):
    return h * (1 + scale) + shift


def axial_rope_tables(n_tokens, dtype):
    t = jnp.arange(n_tokens, dtype=jnp.int32)
    row = (t // GRID_W).astype(jnp.float32)
    col = (t % GRID_W).astype(jnp.float32)
    n_freq = QK_ROPE // 4
    inv = ROPE_BASE ** (-jnp.arange(n_freq, dtype=jnp.float32) / n_freq)
    ar = row[:, None] * inv
    ac = col[:, None] * inv
    ang = jnp.concatenate([ar, ar, ac, ac], axis=-1)[:, None, :]
    return jnp.cos(ang).astype(dtype), jnp.sin(ang).astype(dtype)


def _rotate_half(x):
    x1, x2 = jnp.split(x, 2, axis=-1)
    return jnp.concatenate([-x2, x1], axis=-1)


def apply_axial_rope(x, cos, sin):
    xr, xc = jnp.split(x, 2, axis=-1)
    rot = jnp.concatenate([_rotate_half(xr), _rotate_half(xc)], axis=-1)
    return x * cos + rot * sin


def mla_queries(lat, g_q, w_uq, rope):
    B, L, _ = lat.shape
    cq = rmsnorm(lat[..., :Q_LORA], g_q)
    q = (cq @ w_uq).reshape(B, L, MLA_HEADS, QK_NOPE + QK_ROPE)
    q_nope, q_rope = q[..., :QK_NOPE], q[..., QK_NOPE:]
    if rope is not None:
        q_rope = apply_axial_rope(q_rope, *rope)
    return jnp.concatenate([q_nope, q_rope], axis=-1)


def mla_keys_values(lat, g_kv, w_ukv, rope):
    B, L, _ = lat.shape
    ckv = rmsnorm(lat[..., Q_LORA:Q_LORA + KV_LORA], g_kv)
    kv = (ckv @ w_ukv).reshape(B, L, MLA_HEADS, QK_NOPE + V_DIM)
    k_rope = lat[..., Q_LORA + KV_LORA:][:, :, None, :]
    if rope is not None:
        k_rope = apply_axial_rope(k_rope, *rope)
    k = jnp.concatenate([kv[..., :QK_NOPE], jnp.broadcast_to(k_rope, (B, L, MLA_HEADS, QK_ROPE))], axis=-1)
    return k, kv[..., QK_NOPE:]


def block_attention(q, k, v):
    B, L, H, dq = q.shape
    nb = L // Q_BLOCK
    qb = q.reshape(B, nb, Q_BLOCK, H, dq).transpose(1, 0, 2, 3, 4)
    scale = dq ** -0.5

    def one_block(qi):
        s = jnp.einsum('bqhd,bkhd->bhqk', qi, k).astype(jnp.float32) * scale
        p = jax.nn.softmax(s, axis=-1).astype(v.dtype)
        return jnp.einsum('bhqk,bkhd->bqhd', p, v)

    o = lax.map(one_block, qb)
    return o.transpose(1, 0, 2, 3, 4).reshape(B, L, H * v.shape[-1])


def hyena_filters(L, w1, b1, w2, b2, w3, b3, w4, sin_freq, deltas):
    f32 = jnp.float32
    t = jnp.linspace(0.0, 1.0, L, dtype=f32)[:, None]
    w = (2.0 * math.pi / L) * jnp.arange(L, dtype=f32)[:, None]
    f = jnp.linspace(1e-4, HY_BANDS - 1, HY_BANDS, dtype=f32)[None, :]
    z = jnp.concatenate([t, jnp.cos(f * w), -jnp.sin(f * w)], axis=-1).astype(w1.dtype)
    a = jnp.sin(sin_freq * (z @ w1 + b1))
    a = jnp.sin(sin_freq * (a @ w2 + b2))
    a = jnp.sin(sin_freq * (a @ w3 + b3))
    d = w4.shape[-1] // (2 * HY_ORDER)
    hf = (a @ w4).astype(f32).reshape(L, HY_ORDER, 2, d)
    decay = jnp.exp(-t[:, :, None] * jnp.abs(deltas.astype(f32)))
    hf = hf * decay[:, :, None, :]
    fwd, bwd = hf[:, :, 0], hf[:, :, 1]
    k = jnp.concatenate([fwd, jnp.zeros((1, HY_ORDER, d), f32), bwd[:0:-1]], axis=0)
    k = k / jnp.sum(jnp.abs(k), axis=0, keepdims=True)
    return jnp.fft.rfft(k, axis=0)


def fft_long_conv(u, kf):
    L = u.shape[1]
    U = jnp.fft.rfft(u.astype(jnp.float32), n=2 * L, axis=1)
    y = jnp.fft.irfft(U * kf[None], n=2 * L, axis=1)[:, :L]
    return y.astype(u.dtype)


def hyena_mixer(h, w_in, conv_w, conv_b, w1, b1, w2, b2, w3, b3, w4, sin_freq, deltas, bias, w_out):
    L = h.shape[1]
    p = h @ w_in
    pad = HY_SHORT // 2
    pp = jnp.pad(p, ((0, 0), (pad, pad), (0, 0)))
    acc = conv_b
    for tap in range(HY_SHORT):
        acc = acc + conv_w[tap] * pp[:, tap:tap + L]
    parts = jnp.split(acc, HY_ORDER + 1, axis=-1)
    z = parts[0]
    kf = hyena_filters(L, w1, b1, w2, b2, w3, b3, w4, sin_freq, deltas)
    for n in range(HY_ORDER):
        z = parts[n + 1] * (fft_long_conv(z, kf[:, n]) + bias[n] * z)
    return z @ w_out


def peer(h, wq, keys, u, v):
    shp = h.shape
    D = shp[-1]
    xt = h.reshape(-1, D)
    T = xt.shape[0]
    chunk = math.gcd(T, PEER_CHUNK)

    def one_chunk(xc):
        q = (xc @ wq).reshape(chunk, PEER_HEADS, 2, PEER_DK // 2)
        s = jnp.einsum('thpk,hpnk->thpn', q, keys).astype(jnp.float32)
        sv, si = lax.top_k(s, PEER_TOPK)
        cand = (sv[:, :, 0, :, None] + sv[:, :, 1, None, :]).reshape(chunk, PEER_HEADS, PEER_TOPK * PEER_TOPK)
        cidx = (si[:, :, 0, :, None] * PEER_NK + si[:, :, 1, None, :]).reshape(chunk, PEER_HEADS, PEER_TOPK * PEER_TOPK)
        fs, fi = lax.top_k(cand, PEER_TOPK)
        eidx = jnp.take_along_axis(cidx, fi, axis=-1)
        g = jax.nn.softmax(fs, axis=-1).astype(xc.dtype)
        act = jax.nn.gelu(jnp.einsum('td,thkd->thk', xc, u[eidx]), approximate=False)
        return jnp.einsum('thk,thkd->td', g * act, v[eidx])

    out = lax.map(one_chunk, xt.reshape(T // chunk, chunk, D))
    return out.reshape(shp)


def setup_inputs(seed: int = 0) -> dict:
    key = jax.random.key(seed)
    ks = iter(jax.random.split(key, 48))

    def nrm(shape, scale):
        return jax.random.normal(next(ks), shape, jnp.float32) * scale

    def gain(shape):
        return 1.0 + nrm(shape, 0.02)

    D = D_MODEL
    n_att = (DEPTH + N_MIXERS - 1) // N_MIXERS
    n_hy = DEPTH // N_MIXERS
    decay_lo = -math.log(HY_TARGET) / HY_SLOW_PCT
    decay_hi = -math.log(HY_TARGET) / HY_FAST_PCT
    deltas = jnp.linspace(decay_lo, decay_hi, D, dtype=jnp.float32)
    return {
        "x": nrm((BATCH, SEQ, D), 1.0),
        "c": nrm((BATCH, D), 1.0),
        "ctx": nrm((BATCH, CTX_LEN, D), 1.0),
        "c_ctx": nrm((D,), 1.0),
        "mod_w": nrm((DEPTH, D, 6 * D), 0.5 * D ** -0.5),
        "mod_b": nrm((DEPTH, 6 * D), 0.02),
        "norm_mix_g": gain((DEPTH, D)),
        "norm_ffn_g": gain((DEPTH, D)),
        "final_g": gain((D,)),
        "mla_w_dkv": nrm((n_att, D, Q_LORA + KV_LORA + QK_ROPE), D ** -0.5),
        "mla_q_norm_g": gain((n_att, Q_LORA)),
        "mla_w_uq": nrm((n_att, Q_LORA, MLA_HEADS * (QK_NOPE + QK_ROPE)), Q_LORA ** -0.5),
        "mla_kv_norm_g": gain((n_att, KV_LORA)),
        "mla_w_ukv": nrm((n_att, KV_LORA, MLA_HEADS * (QK_NOPE + V_DIM)), KV_LORA ** -0.5),
        "mla_w_o": nrm((n_att, MLA_HEADS * V_DIM, D), (MLA_HEADS * V_DIM) ** -0.5),
        "hy_w_in": nrm((n_hy, D, (HY_ORDER + 1) * D), D ** -0.5),
        "hy_conv_w": nrm((n_hy, HY_SHORT, (HY_ORDER + 1) * D), HY_SHORT ** -0.5),
        "hy_conv_b": nrm((n_hy, (HY_ORDER + 1) * D), 0.02),
        "hy_w1": nrm((n_hy, HY_EMB, HY_FFN), HY_EMB ** -0.5),
        "hy_b1": nrm((n_hy, HY_FFN), 0.1),
        "hy_w2": nrm((n_hy, HY_FFN, HY_FFN), HY_FFN ** -0.5),
        "hy_b2": nrm((n_hy, HY_FFN), 0.1),
        "hy_w3": nrm((n_hy, HY_FFN, HY_FFN), HY_FFN ** -0.5),
        "hy_b3": nrm((n_hy, HY_FFN), 0.1),
        "hy_w4": nrm((n_hy, HY_FFN, HY_ORDER * 2 * D), HY_FFN ** -0.5),
        "hy_sin_freq": gain((n_hy, HY_FFN)),
        "hy_deltas": deltas * gain((n_hy, HY_ORDER, D)),
        "hy_bias": nrm((n_hy, HY_ORDER, D), 1.0),
        "hy_w_out": nrm((n_hy, D, D), D ** -0.5),
        "peer_wq": nrm((DEPTH, D, PEER_HEADS * PEER_DK), D ** -0.5),
        "peer_keys": nrm((DEPTH, PEER_HEADS, 2, PEER_NK, PEER_DK // 2), (PEER_DK // 2) ** -0.5),
        "peer_u": nrm((DEPTH, PEER_EXPERTS, D), D ** -0.5),
        "peer_v": nrm((DEPTH, PEER_EXPERTS, D), 1.0),
    }


def reference(x, c, ctx, c_ctx, mod_w, mod_b, norm_mix_g, norm_ffn_g, final_g,
              mla_w_dkv, mla_q_norm_g, mla_w_uq, mla_kv_norm_g, mla_w_ukv, mla_w_o,
              hy_w_in, hy_conv_w, hy_conv_b, hy_w1, hy_b1, hy_w2, hy_b2, hy_w3, hy_b3, hy_w4,
              hy_sin_freq, hy_deltas, hy_bias, hy_w_out,
              peer_wq, peer_keys, peer_u, peer_v):
    S = x.shape[1]
    rope = axial_rope_tables(S, x.dtype)
    sc = jax.nn.silu(c)
    sc_ctx = jax.nn.silu(c_ctx)
    for i in range(DEPTH):
        j = i // N_MIXERS
        ctx_read_later = any(l % N_MIXERS == 0 for l in range(i + 1, DEPTH))
        m_lat = jnp.split((sc @ mod_w[i] + mod_b[i])[:, None, :], 6, axis=-1)
        m_ctx = jnp.split(sc_ctx @ mod_w[i] + mod_b[i], 6, axis=-1)

        hl = modulate(rmsnorm(x, norm_mix_g[i]), m_lat[0], m_lat[1])
        if i % N_MIXERS == 0:
            hc = modulate(rmsnorm(ctx, norm_mix_g[i]), m_ctx[0], m_ctx[1])
            lat_l = hl @ mla_w_dkv[j]
            lat_c = hc @ mla_w_dkv[j]
            kl, vl = mla_keys_values(lat_l, mla_kv_norm_g[j], mla_w_ukv[j], rope)
            kc, vc = mla_keys_values(lat_c, mla_kv_norm_g[j], mla_w_ukv[j], None)
            ql = mla_queries(lat_l, mla_q_norm_g[j], mla_w_uq[j], rope)
            k_all = jnp.concatenate([kl, kc], axis=1)
            v_all = jnp.concatenate([vl, vc], axis=1)
            yl = block_attention(ql, k_all, v_all) @ mla_w_o[j]
            if ctx_read_later:
                qc = mla_queries(lat_c, mla_q_norm_g[j], mla_w_uq[j], None)
                yc = block_attention(qc, kc, vc) @ mla_w_o[j]
        else:
            hy = (hy_w_in[j], hy_conv_w[j], hy_conv_b[j], hy_w1[j], hy_b1[j], hy_w2[j], hy_b2[j],
                  hy_w3[j], hy_b3[j], hy_w4[j], hy_sin_freq[j], hy_deltas[j], hy_bias[j], hy_w_out[j])
            yl = hyena_mixer(hl, *hy)
            if ctx_read_later:
                hc = modulate(rmsnorm(ctx, norm_mix_g[i]), m_ctx[0], m_ctx[1])
                yc = hyena_mixer(hc, *hy)
        x = x + m_lat[2] * yl
        if ctx_read_later:
            ctx = ctx + m_ctx[2] * yc

        hl = modulate(rmsnorm(x, norm_ffn_g[i]), m_lat[3], m_lat[4])
        x = x + m_lat[5] * peer(hl, peer_wq[i], peer_keys[i], peer_u[i], peer_v[i])
        if ctx_read_later:
            hc = modulate(rmsnorm(ctx, norm_ffn_g[i]), m_ctx[3], m_ctx[4])
            ctx = ctx + m_ctx[5] * peer(hc, peer_wq[i], peer_keys[i], peer_u[i], peer_v[i])
    return rmsnorm(x, final_g)
```

```cpp
#include <hip/hip_runtime.h>
#include <hip/hip_bf16.h>
#include <stdint.h>
#include <math.h>

#define D_MODEL 1024
#define BATCH 8
#define SEQ 4096
#define CTXL 256
#define NH 16
#define QLORA 384
#define KVLORA 256
#define DLAT 672
#define PEER_NK 128
#define FILT_L 4096

__device__ __forceinline__ float warp_sum(float v) {
#pragma unroll
    for (int o = 32; o > 0; o >>= 1) v += __shfl_xor(v, o);
    return v;
}
__device__ __forceinline__ float block_sum256(float v, float* red) {
    v = warp_sum(v);
    __syncthreads();
    if ((threadIdx.x & 63) == 0) red[threadIdx.x >> 6] = v;
    __syncthreads();
    float r = red[0] + red[1] + red[2] + red[3];
    return r;
}

__global__ void nk_mod(const float* __restrict__ c, const float* __restrict__ c_ctx,
                       const float* __restrict__ mod_w, const float* __restrict__ mod_b,
                       float* __restrict__ modv) {
    int j = blockIdx.x * 256 + threadIdx.x;
    int i = blockIdx.y;
    __shared__ float sc[9][1024];
    for (int e = threadIdx.x; e < 9 * 1024; e += 256) {
        int r = e >> 10, k = e & 1023;
        float v = (r < 8) ? c[r * 1024 + k] : c_ctx[k];
        sc[r][k] = v / (1.f + expf(-v));
    }
    __syncthreads();
    float acc[9];
#pragma unroll
    for (int r = 0; r < 9; ++r) acc[r] = 0.f;
    for (int k = 0; k < 1024; ++k) {
        float w = mod_w[((size_t)i * 1024 + k) * 6144 + j];
#pragma unroll
        for (int r = 0; r < 9; ++r) acc[r] += sc[r][k] * w;
    }
    float b = mod_b[i * 6144 + j];
#pragma unroll
    for (int r = 0; r < 9; ++r) modv[((size_t)i * 9 + r) * 6144 + j] = acc[r] + b;
}

__global__ void nk_normmod(const float* __restrict__ x, const float* __restrict__ g,
                           const float* __restrict__ shift, const float* __restrict__ scale,
                           float* __restrict__ out) {
    __shared__ float red[4];
    size_t row = blockIdx.x;
    const float* xr = x + row * 1024;
    float v[4];
    float ss = 0.f;
#pragma unroll
    for (int i = 0; i < 4; ++i) { v[i] = xr[threadIdx.x + 256 * i]; ss += v[i] * v[i]; }
    ss = block_sum256(ss, red);
    float rs = rsqrtf(ss * (1.f / 1024.f) + 1e-6f);
#pragma unroll
    for (int i = 0; i < 4; ++i) {
        int j = threadIdx.x + 256 * i;
        float y = v[i] * rs * g[j];
        if (shift) y = y * (1.f + scale[j]) + shift[j];
        out[row * 1024 + j] = y;
    }
}

__global__ void nk_gemm(const float* __restrict__ A, int lda, const float* __restrict__ B, int ldb,
                        float* __restrict__ C, int ldc, int M, int N, int K) {
    __shared__ float As[16][64 + 4];
    __shared__ float Bs[16][64 + 4];
    int tx = threadIdx.x & 15, ty = threadIdx.x >> 4;
    int m0 = blockIdx.y * 64, n0 = blockIdx.x * 64;
    float acc[4][4];
#pragma unroll
    for (int i = 0; i < 4; ++i)
#pragma unroll
        for (int j = 0; j < 4; ++j) acc[i][j] = 0.f;
    for (int k0 = 0; k0 < K; k0 += 16) {
        for (int e = threadIdx.x; e < 64 * 16; e += 256) {
            int r = e >> 4, kk = e & 15;
            int m = m0 + r;
            As[kk][r] = (m < M) ? A[(size_t)m * lda + k0 + kk] : 0.f;
        }
        for (int e = threadIdx.x; e < 64 * 16; e += 256) {
            int kk = e >> 6, cc = e & 63;
            int n = n0 + cc;
            Bs[kk][cc] = (n < N) ? B[(size_t)(k0 + kk) * ldb + n] : 0.f;
        }
        __syncthreads();
#pragma unroll
        for (int kk = 0; kk < 16; ++kk) {
            float a[4], b[4];
#pragma unroll
            for (int i = 0; i < 4; ++i) a[i] = As[kk][ty * 4 + i];
#pragma unroll
            for (int j = 0; j < 4; ++j) b[j] = Bs[kk][tx * 4 + j];
#pragma unroll
            for (int i = 0; i < 4; ++i)
#pragma unroll
                for (int j = 0; j < 4; ++j) acc[i][j] += a[i] * b[j];
        }
        __syncthreads();
    }
#pragma unroll
    for (int i = 0; i < 4; ++i) {
        int m = m0 + ty * 4 + i;
        if (m >= M) continue;
#pragma unroll
        for (int j = 0; j < 4; ++j) {
            int n = n0 + tx * 4 + j;
            if (n < N) C[(size_t)m * ldc + n] = acc[i][j];
        }
    }
}

__device__ __forceinline__ void rope32(const float* in, float* out, int t) {
    float row = (float)(t / 64), col = (float)(t % 64);
#pragma unroll
    for (int i = 0; i < 8; ++i) {
        float inv = powf(10000.f, -(float)i / 8.f);
        float ar = row * inv, ac = col * inv;
        float cr = cosf(ar), sr = sinf(ar), cc = cosf(ac), sn = sinf(ac);
        out[i] = in[i] * cr - in[i + 8] * sr;
        out[i + 8] = in[i + 8] * cr + in[i] * sr;
        out[16 + i] = in[16 + i] * cc - in[24 + i] * sn;
        out[24 + i] = in[24 + i] * cc + in[16 + i] * sn;
    }
}

__global__ void __launch_bounds__(256) nk_latpost(const float* __restrict__ lat, const float* __restrict__ gq, const float* __restrict__ gkv,
                           float* __restrict__ cq, float* __restrict__ ckv, float* __restrict__ kr, int n_lat) {
    __shared__ float red[4];
    int row = blockIdx.x;
    const float* l = lat + (size_t)row * DLAT;
    int tid = threadIdx.x;
    float q0 = l[tid], q1 = (tid < 128) ? l[256 + tid] : 0.f;
    float ssq = block_sum256(q0 * q0 + q1 * q1, red);
    float rq = rsqrtf(ssq * (1.f / 384.f) + 1e-6f);
    float k0 = l[384 + tid];
    float ssk = block_sum256(k0 * k0, red);
    float rk = rsqrtf(ssk * (1.f / 256.f) + 1e-6f);
    if (row < n_lat) {
        cq[(size_t)row * QLORA + tid] = q0 * rq * gq[tid];
        if (tid < 128) cq[(size_t)row * QLORA + 256 + tid] = q1 * rq * gq[256 + tid];
    }
    ckv[(size_t)row * KVLORA + tid] = k0 * rk * gkv[tid];
    if (tid == 0) {
        float in[32], out[32];
#pragma unroll
        for (int i = 0; i < 32; ++i) in[i] = l[640 + i];
        if (row < n_lat) rope32(in, out, row);
        else {
#pragma unroll
            for (int i = 0; i < 32; ++i) out[i] = in[i];
        }
#pragma unroll
        for (int i = 0; i < 32; ++i) kr[(size_t)row * 32 + i] = out[i];
    }
}

__global__ void __launch_bounds__(256) nk_ropeq(float* __restrict__ q, int n_tok) {
    int idx = blockIdx.x * 256 + threadIdx.x;
    if (idx >= n_tok * NH) return;
    int t = idx / NH, h = idx % NH;
    float* p = q + (size_t)t * (NH * 96) + h * 96 + 64;
    float in[32], out[32];
#pragma unroll
    for (int i = 0; i < 32; ++i) in[i] = p[i];
    rope32(in, out, t);
#pragma unroll
    for (int i = 0; i < 32; ++i) p[i] = out[i];
}

__global__ void __launch_bounds__(256) nk_attn(const float* __restrict__ q, const float* __restrict__ kv,
                                                const float* __restrict__ kr, float* __restrict__ out, int n_keys) {
    __shared__ float Ks[32][96];
    __shared__ float Vs[32][64];
    int h = blockIdx.y;
    int t = blockIdx.x * 256 + threadIdx.x;
    float qr[96], o[64];
    const float scale = 0.10206207261596575f;
#pragma unroll
    for (int d = 0; d < 96; ++d) qr[d] = q[(size_t)t * (NH * 96) + h * 96 + d] * scale;
#pragma unroll
    for (int d = 0; d < 64; ++d) o[d] = 0.f;
    float m = -1e30f, l = 0.f;
    for (int k0 = 0; k0 < n_keys; k0 += 32) {
        __syncthreads();
        for (int e = threadIdx.x; e < 32 * 96; e += 256) {
            int j = e / 96, d = e % 96;
            float v = (d < 64) ? kv[(size_t)(k0 + j) * (NH * 128) + h * 128 + d] : kr[(size_t)(k0 + j) * 32 + (d - 64)];
            Ks[j][d] = v;
        }
        for (int e = threadIdx.x; e < 32 * 64; e += 256) {
            int j = e >> 6, d = e & 63;
            Vs[j][d] = kv[(size_t)(k0 + j) * (NH * 128) + h * 128 + 64 + d];
        }
        __syncthreads();
        for (int j = 0; j < 32; ++j) {
            float s = 0.f;
#pragma unroll
            for (int d = 0; d < 96; ++d) s += qr[d] * Ks[j][d];
            float mn = fmaxf(m, s);
            float corr = __expf(m - mn);
            float p = __expf(s - mn);
            l = l * corr + p;
#pragma unroll
            for (int d = 0; d < 64; ++d) o[d] = o[d] * corr + p * Vs[j][d];
            m = mn;
        }
    }
    float inv = 1.f / l;
#pragma unroll
    for (int d = 0; d < 64; ++d) out[(size_t)t * (NH * 64) + h * 64 + d] = o[d] * inv;
}

__global__ void nk_resid(const float* __restrict__ xi, const float* __restrict__ y, const float* __restrict__ gate,
                         float* __restrict__ xo, size_t n) {
    size_t i = (size_t)blockIdx.x * 256 + threadIdx.x;
    if (i >= n) return;
    int j = (int)(i & 1023);
    xo[i] = xi[i] + gate[j] * y[i];
}

__global__ void __launch_bounds__(256) nk_route(const float* __restrict__ pq, const float* __restrict__ keys,
                                                 int* __restrict__ eidx, float* __restrict__ gw) {
    __shared__ float s[16][128];
    __shared__ float sv[16][16];
    __shared__ int si[16][16];
    __shared__ float cand[8][256];
    __shared__ float fsv[8][16];
    __shared__ int fiv[8][16];
    int tok = blockIdx.x, tid = threadIdx.x;
    {
        int hp = tid >> 4, n0 = (tid & 15) * 8;
        const float* qv = pq + (size_t)tok * 2048 + hp * 128;
        for (int nn = 0; nn < 8; ++nn) {
            const float* kp = keys + ((size_t)hp * 128 + n0 + nn) * 128;
            float a = 0.f;
            for (int k = 0; k < 128; ++k) a += qv[k] * kp[k];
            s[hp][n0 + nn] = a;
        }
    }
    __syncthreads();
    if (tid < 16) {
        for (int r = 0; r < 16; ++r) {
            float best = -INFINITY; int bi = 0;
            for (int n = 0; n < 128; ++n) { float v = s[tid][n]; if (v > best) { best = v; bi = n; } }
            sv[tid][r] = best; si[tid][r] = bi; s[tid][bi] = -INFINITY;
        }
    }
    __syncthreads();
    {
        int h = tid >> 5;
        for (int e = (tid & 31); e < 256; e += 32) cand[h][e] = sv[h * 2][e >> 4] + sv[h * 2 + 1][e & 15];
    }
    __syncthreads();
    if (tid < 8) {
        int h = tid;
        for (int r = 0; r < 16; ++r) {
            float best = -INFINITY; int bi = 0;
            for (int n = 0; n < 256; ++n) { float v = cand[h][n]; if (v > best) { best = v; bi = n; } }
            fsv[h][r] = best; fiv[h][r] = bi; cand[h][bi] = -INFINITY;
        }
        float mx = fsv[h][0], sum = 0.f;
        for (int r = 0; r < 16; ++r) { float e = expf(fsv[h][r] - mx); fsv[h][r] = e; sum += e; }
        for (int r = 0; r < 16; ++r) {
            int f = fiv[h][r];
            int i1 = si[h * 2][f >> 4], i2 = si[h * 2 + 1][f & 15];
            eidx[((size_t)tok * 8 + h) * 16 + r] = i1 * 128 + i2;
            gw[((size_t)tok * 8 + h) * 16 + r] = fsv[h][r] / sum;
        }
    }
}

__global__ void __launch_bounds__(256) nk_gather(const float* __restrict__ hbuf, const float* __restrict__ U,
                                                  const float* __restrict__ V, const int* __restrict__ eidx,
                                                  const float* __restrict__ gw, const float* __restrict__ xi,
                                                  const float* __restrict__ gate, float* __restrict__ xo) {
    __shared__ float red[2][4];
    __shared__ int se[128];
    __shared__ float sg[128];
    int tok = blockIdx.x, tid = threadIdx.x;
    if (tid < 128) { se[tid] = eidx[(size_t)tok * 128 + tid]; sg[tid] = gw[(size_t)tok * 128 + tid]; }
    float hv[4], acc[4];
#pragma unroll
    for (int i = 0; i < 4; ++i) { hv[i] = hbuf[(size_t)tok * 1024 + tid + 256 * i]; acc[i] = 0.f; }
    __syncthreads();
    for (int e = 0; e < 128; ++e) {
        const float* u = U + (size_t)se[e] * 1024;
        const float* v = V + (size_t)se[e] * 1024;
        float uv[4], vv[4];
#pragma unroll
        for (int i = 0; i < 4; ++i) { uv[i] = u[tid + 256 * i]; vv[i] = v[tid + 256 * i]; }
        float p = uv[0] * hv[0] + uv[1] * hv[1] + uv[2] * hv[2] + uv[3] * hv[3];
        p = warp_sum(p);
        if ((tid & 63) == 0) red[e & 1][tid >> 6] = p;
        __syncthreads();
        float d = red[e & 1][0] + red[e & 1][1] + red[e & 1][2] + red[e & 1][3];
        float a = sg[e] * 0.5f * d * (1.f + erff(d * 0.70710678118654752f));
#pragma unroll
        for (int i = 0; i < 4; ++i) acc[i] += a * vv[i];
    }
#pragma unroll
    for (int i = 0; i < 4; ++i) {
        int j = tid + 256 * i;
        xo[(size_t)tok * 1024 + j] = xi[(size_t)tok * 1024 + j] + gate[j] * acc[i];
    }
}

__global__ void nk_filt_mlp(const float* __restrict__ w1, const float* __restrict__ b1, const float* __restrict__ w2,
                            const float* __restrict__ b2, const float* __restrict__ w3, const float* __restrict__ b3,
                            const float* __restrict__ freq, float* __restrict__ a3) {
    __shared__ float z[33];
    __shared__ float a[2][64];
    int pos = blockIdx.x, j = threadIdx.x;
    const float L = (float)FILT_L;
    if (j < 33) {
        float t = (float)pos / (L - 1.f);
        float w = (2.0f * 3.14159265358979323846f / L) * (float)pos;
        float v;
        if (j == 0) v = t;
        else {
            int b = (j - 1) & 15;
            float f = 1e-4f + (float)b * ((15.f - 1e-4f) / 15.f);
            v = (j <= 16) ? cosf(f * w) : -sinf(f * w);
        }
        z[j] = v;
    }
    __syncthreads();
    float fr = freq[j];
    float acc = b1[j];
    for (int k = 0; k < 33; ++k) acc += z[k] * w1[k * 64 + j];
    a[0][j] = sinf(fr * acc);
    __syncthreads();
    acc = b2[j];
    for (int k = 0; k < 64; ++k) acc += a[0][k] * w2[k * 64 + j];
    a[1][j] = sinf(fr * acc);
    __syncthreads();
    acc = b3[j];
    for (int k = 0; k < 64; ++k) acc += a[1][k] * w3[k * 64 + j];
    a3[(size_t)pos * 64 + j] = sinf(fr * acc);
}

__global__ void nk_filt_fin(const float* __restrict__ hf, const float* __restrict__ deltas, float* __restrict__ kf) {
    __shared__ float red[4];
    int nc = blockIdx.x;
    int n = nc >> 10, c = nc & 1023;
    float ad = fabsf(deltas[n * 1024 + c]);
    float* out = kf + (size_t)nc * 8192;
    float asum = 0.f;
    for (int m = threadIdx.x; m < 8192; m += 256) {
        float v;
        if (m < 4096) {
            float t = (float)m / 4095.f;
            v = hf[(size_t)m * 4096 + n * 2048 + c] * expf(-t * ad);
        } else if (m == 4096) v = 0.f;
        else {
            int tau = 8192 - m;
            float t = (float)tau / 4095.f;
            v = hf[(size_t)tau * 4096 + n * 2048 + 1024 + c] * expf(-t * ad);
        }
        out[m] = v;
        asum += fabsf(v);
    }
    asum = block_sum256(asum, red);
    float inv = 1.f / asum;
    for (int m = threadIdx.x; m < 8192; m += 256) out[m] *= inv;
}

__global__ void nk_shortconv(const float* __restrict__ p, const float* __restrict__ cw, const float* __restrict__ cb,
                             float* __restrict__ sc) {
    size_t i = (size_t)blockIdx.x * 256 + threadIdx.x;
    int ch = (int)(i % 3072);
    int t = (int)(i / 3072);
    float a = cb[ch] + cw[3072 + ch] * p[i];
    if (t > 0) a += cw[ch] * p[i - 3072];
    if (t < 4095) a += cw[2 * 3072 + ch] * p[i + 3072];
    sc[i] = a;
}

__global__ void __launch_bounds__(256) nk_longconv(const float* __restrict__ kf, const float* __restrict__ zin, int ldz,
                                                    const float* __restrict__ xm, int ldx, const float* __restrict__ bias,
                                                    float* __restrict__ zout) {
    __shared__ float fs[8192];
    __shared__ float us[4096];
    int c = blockIdx.x, tid = threadIdx.x;
    for (int m = tid; m < 8192; m += 256) fs[m] = kf[(size_t)c * 8192 + m];
    for (int s = tid; s < 4096; s += 256) us[s] = zin[(size_t)s * ldz + c];
    __syncthreads();
    float acc[16];
#pragma unroll
    for (int i = 0; i < 16; ++i) acc[i] = 0.f;
    for (int s = 0; s < 4096; ++s) {
        float u = us[s];
        int base = (tid - s) & 8191;
#pragma unroll
        for (int i = 0; i < 16; ++i) acc[i] += fs[(base + 256 * i) & 8191] * u;
    }
    float b = bias[c];
#pragma unroll
    for (int i = 0; i < 16; ++i) {
        int t = tid + 256 * i;
        zout[(size_t)t * 1024 + c] = xm[(size_t)t * ldx + c] * (acc[i] + b * us[t]);
    }
}

static inline size_t align_up(size_t v, size_t a) { return (v + a - 1) / a * a; }

extern "C" void kernel_launch(void* const* d_in, const int* in_sizes, int n_in, void* d_out, int out_size, void* d_ws,
                              size_t ws_size, hipStream_t stream) {
    const float* x = (const float*)d_in[0];
    const float* c = (const float*)d_in[1];
    const float* ctx = (const float*)d_in[2];
    const float* c_ctx = (const float*)d_in[3];
    const float* mod_w = (const float*)d_in[4];
    const float* mod_b = (const float*)d_in[5];
    const float* norm_mix_g = (const float*)d_in[6];
    const float* norm_ffn_g = (const float*)d_in[7];
    const float* final_g = (const float*)d_in[8];
    const float* w_dkv = (const float*)d_in[9];
    const float* q_norm_g = (const float*)d_in[10];
    const float* w_uq = (const float*)d_in[11];
    const float* kv_norm_g = (const float*)d_in[12];
    const float* w_ukv = (const float*)d_in[13];
    const float* w_o = (const float*)d_in[14];
    const float* hy_w_in = (const float*)d_in[15];
    const float* hy_conv_w = (const float*)d_in[16];
    const float* hy_conv_b = (const float*)d_in[17];
    const float* hy_w1 = (const float*)d_in[18];
    const float* hy_b1 = (const float*)d_in[19];
    const float* hy_w2 = (const float*)d_in[20];
    const float* hy_b2 = (const float*)d_in[21];
    const float* hy_w3 = (const float*)d_in[22];
    const float* hy_b3 = (const float*)d_in[23];
    const float* hy_w4 = (const float*)d_in[24];
    const float* hy_freq = (const float*)d_in[25];
    const float* hy_deltas = (const float*)d_in[26];
    const float* hy_bias = (const float*)d_in[27];
    const float* hy_w_out = (const float*)d_in[28];
    const float* peer_wq = (const float*)d_in[29];
    const float* peer_keys = (const float*)d_in[30];
    const float* peer_u = (const float*)d_in[31];
    const float* peer_v = (const float*)d_in[32];
    float* out = (float*)d_out;

    char* ws = (char*)d_ws;
    size_t off = 0;
    auto alloc = [&](size_t bytes) { void* p = ws + off; off = align_up(off + bytes, 256); return p; };
    float* modv = (float*)alloc(2 * 9 * 6144 * 4);
    float* a3 = (float*)alloc(4096 * 64 * 4);
    float* hf = (float*)alloc((size_t)4096 * 4096 * 4);
    float* kf = (float*)alloc((size_t)2048 * 8192 * 4);
    const int NT = SEQ + CTXL;
    float* H = (float*)alloc((size_t)NT * 1024 * 4);
    float* LAT = (float*)alloc((size_t)NT * DLAT * 4);
    float* CQ = (float*)alloc((size_t)SEQ * QLORA * 4);
    float* CKV = (float*)alloc((size_t)NT * KVLORA * 4);
    float* KR = (float*)alloc((size_t)NT * 32 * 4);
    float* Q = (float*)alloc((size_t)SEQ * 1536 * 4);
    float* KV = (float*)alloc((size_t)NT * 2048 * 4);
    float* ATT = (float*)alloc((size_t)SEQ * 1024 * 4);
    float* Y = (float*)alloc((size_t)SEQ * 1024 * 4);
    float* XA = (float*)alloc((size_t)SEQ * 1024 * 4);
    float* XB = (float*)alloc((size_t)SEQ * 1024 * 4);
    float* PQ = (float*)alloc((size_t)SEQ * 2048 * 4);
    int* EIDX = (int*)alloc((size_t)SEQ * 128 * 4);
    float* GW = (float*)alloc((size_t)SEQ * 128 * 4);
    float* P = (float*)alloc((size_t)SEQ * 3072 * 4);
    float* SC = (float*)alloc((size_t)SEQ * 3072 * 4);
    float* Z1 = (float*)alloc((size_t)SEQ * 1024 * 4);
    float* Z2 = (float*)alloc((size_t)SEQ * 1024 * 4);

    auto gemm = [&](const float* A, int lda, const float* B, int ldb, float* C, int ldc, int M, int N, int K) {
        dim3 g((N + 63) / 64, (M + 63) / 64);
        nk_gemm<<<g, 256, 0, stream>>>(A, lda, B, ldb, C, ldc, M, N, K);
    };

    nk_mod<<<dim3(6144 / 256, 2), 256, 0, stream>>>(c, c_ctx, mod_w, mod_b, modv);
    nk_filt_mlp<<<4096, 64, 0, stream>>>(hy_w1, hy_b1, hy_w2, hy_b2, hy_w3, hy_b3, hy_freq, a3);
    gemm(a3, 64, hy_w4, 4096, hf, 4096, 4096, 4096, 64);
    nk_filt_fin<<<2048, 256, 0, stream>>>(hf, hy_deltas, kf);

    for (int b = 0; b < BATCH; ++b) {
        const float* xb = x + (size_t)b * SEQ * 1024;
        const float* cb = ctx + (size_t)b * CTXL * 1024;
        const float* m0 = modv + ((size_t)0 * 9 + b) * 6144;
        const float* m0c = modv + ((size_t)0 * 9 + 8) * 6144;
        const float* m1 = modv + ((size_t)1 * 9 + b) * 6144;
        nk_normmod<<<SEQ, 256, 0, stream>>>(xb, norm_mix_g, m0, m0 + 1024, H);
        nk_normmod<<<CTXL, 256, 0, stream>>>(cb, norm_mix_g, m0c, m0c + 1024, H + (size_t)SEQ * 1024);
        gemm(H, 1024, w_dkv, DLAT, LAT, DLAT, NT, DLAT, 1024);
        nk_latpost<<<NT, 256, 0, stream>>>(LAT, q_norm_g, kv_norm_g, CQ, CKV, KR, SEQ);
        gemm(CQ, QLORA, w_uq, 1536, Q, 1536, SEQ, 1536, QLORA);
        nk_ropeq<<<(SEQ * NH + 255) / 256, 256, 0, stream>>>(Q, SEQ);
        gemm(CKV, KVLORA, w_ukv, 2048, KV, 2048, NT, 2048, KVLORA);
        nk_attn<<<dim3(SEQ / 256, NH), 256, 0, stream>>>(Q, KV, KR, ATT, NT);
        gemm(ATT, 1024, w_o, 1024, Y, 1024, SEQ, 1024, 1024);
        nk_resid<<<SEQ * 1024 / 256, 256, 0, stream>>>(xb, Y, m0 + 2 * 1024, XA, (size_t)SEQ * 1024);
        nk_normmod<<<SEQ, 256, 0, stream>>>(XA, norm_ffn_g, m0 + 3 * 1024, m0 + 4 * 1024, H);
        gemm(H, 1024, peer_wq, 2048, PQ, 2048, SEQ, 2048, 1024);
        nk_route<<<SEQ, 256, 0, stream>>>(PQ, peer_keys, EIDX, GW);
        nk_gather<<<SEQ, 256, 0, stream>>>(H, peer_u, peer_v, EIDX, GW, XA, m0 + 5 * 1024, XB);
        nk_normmod<<<SEQ, 256, 0, stream>>>(XB, norm_mix_g + 1024, m1, m1 + 1024, H);
        gemm(H, 1024, hy_w_in, 3072, P, 3072, SEQ, 3072, 1024);
        nk_shortconv<<<SEQ * 3072 / 256, 256, 0, stream>>>(P, hy_conv_w, hy_conv_b, SC);
        nk_longconv<<<1024, 256, 0, stream>>>(kf, SC, 3072, SC + 1024, 3072, hy_bias, Z1);
        nk_longconv<<<1024, 256, 0, stream>>>(kf + (size_t)1024 * 8192, Z1, 1024, SC + 2048, 3072, hy_bias + 1024, Z2);
        gemm(Z2, 1024, hy_w_out, 1024, Y, 1024, SEQ, 1024, 1024);
        nk_resid<<<SEQ * 1024 / 256, 256, 0, stream>>>(XB, Y, m1 + 2 * 1024, XA, (size_t)SEQ * 1024);
        nk_normmod<<<SEQ, 256, 0, stream>>>(XA, norm_ffn_g + 1024, m1 + 3 * 1024, m1 + 4 * 1024, H);
        gemm(H, 1024, peer_wq + (size_t)1024 * 2048, 2048, PQ, 2048, SEQ, 2048, 1024);
        nk_route<<<SEQ, 256, 0, stream>>>(PQ, peer_keys + (size_t)16 * 128 * 128, EIDX, GW);
        nk_gather<<<SEQ, 256, 0, stream>>>(H, peer_u + (size_t)16384 * 1024, peer_v + (size_t)16384 * 1024, EIDX, GW, XA,
                                            m1 + 5 * 1024, XB);
        nk_normmod<<<SEQ, 256, 0, stream>>>(XB, final_g, nullptr, nullptr, out + (size_t)b * SEQ * 1024);
    }
}
```

```cpp
#include <hip/hip_runtime.h>
#include <hip/hip_cooperative_groups.h>
#include <stdint.h>
#include <math.h>
#include <cstdio>

#ifndef DUPSET
#define DUPSET 0u
#endif
#define OPT_PHASES 21

#define D_MODEL 1024
#define BATCH 8
#define SEQ 4096
#define CTXL 256
#define NH 16
#define QLORA 384
#define KVLORA 256
#define DLAT 672
#define PEER_NK 128
#define FILT_L 4096

__device__ __forceinline__ float warp_sum(float v) {
#pragma unroll
    for (int o = 32; o > 0; o >>= 1) v += __shfl_xor(v, o);
    return v;
}

namespace cg = cooperative_groups;
#define LAS __attribute__((address_space(3)))
#define PG8_LAS LAS
typedef unsigned short bf16_t;
typedef short bf16x8 __attribute__((ext_vector_type(8)));
typedef float f32x4 __attribute__((ext_vector_type(4)));
typedef float f32x16 __attribute__((ext_vector_type(16)));
typedef unsigned u32x4 __attribute__((ext_vector_type(4)));
typedef unsigned u32x2 __attribute__((ext_vector_type(2)));


__device__ __forceinline__ int lane_id() { int l; asm volatile("v_mbcnt_lo_u32_b32 %0, -1, 0\n\tv_mbcnt_hi_u32_b32 %0, -1, %0" : "=v"(l)); return l; }
#define MYTID ((g_wave << 6) | lane_id())
__device__ __forceinline__ unsigned cvt_pk_bf16(float lo, float hi) { unsigned r; asm("v_cvt_pk_bf16_f32 %0, %1, %2" : "=v"(r) : "v"(lo), "v"(hi)); return r; }
__device__ __forceinline__ float bf2f(unsigned b) { return __uint_as_float(b << 16); }
__device__ __forceinline__ float bflo(unsigned w) { return __uint_as_float(w << 16); }
__device__ __forceinline__ float bfhi(unsigned w) { return __uint_as_float(w & 0xffff0000u); }
__device__ __forceinline__ bf16_t f2bf(float f) { return (bf16_t)(cvt_pk_bf16(f, f) & 0xffffu); }

constexpr int NTOK = BATCH * SEQ;
constexpr int NROW = BATCH * (SEQ + CTXL);
constexpr int RPB = SEQ + CTXL;

constexpr size_t KiB = 1024, MiB = 1024 * 1024;
constexpr size_t WS_CTL = 0;
constexpr size_t WS_MODV = 64 * KiB;
constexpr size_t WS_ROPE = 512 * KiB;
constexpr size_t WS_RQ = 1 * MiB;
constexpr size_t WS_RK = 1 * MiB + 160 * KiB;
constexpr size_t WS_FNORM = 1 * MiB + 320 * KiB;
constexpr size_t WS_A3 = 2 * MiB;
constexpr size_t WS_PSC = 3 * MiB;
constexpr size_t WS_WDKV = 4 * MiB;
constexpr size_t WS_WUQ = 5 * MiB + 512 * KiB;
constexpr size_t WS_WK = 7 * MiB;
constexpr size_t WS_WV = 7 * MiB + 512 * KiB;
constexpr size_t WS_WO = 8 * MiB;
constexpr size_t WS_WOUT = 10 * MiB;
constexpr size_t WS_WIN = 12 * MiB;
constexpr size_t WS_WQ = 18 * MiB;
constexpr size_t WS_KEYS = 26 * MiB;
constexpr size_t WS_FILT = 28 * MiB;
constexpr size_t WS_X = 60 * MiB;
constexpr size_t WS_PT = 188 * MiB;
constexpr size_t WS_T0 = 252 * MiB;
constexpr size_t WS_KB = 348 * MiB;
constexpr size_t WS_VT = 416 * MiB;
constexpr size_t WS_KR = 484 * MiB;
constexpr size_t WS_END = 487 * MiB;
constexpr size_t OUT_OB = 0;
constexpr size_t OUT_LAT = 64 * MiB;

struct MP {
    const float* in[33];
    float* out;
    unsigned char* ws;
    int ph_lo, ph_hi;
};

constexpr int BM = 256, BK = 64, HALF = 128, HTB = HALF * BK * 2, STAGE_BYTES = 8 * HTB, NXCD = 8, WGM = 1;
__host__ __device__ __forceinline__ int lds_byte(int r, int c) { const int st = (r >> 4) * 2 + (c >> 5), rr = r & 15, cc = c & 31, ob = rr * 64 + cc * 2; return st * 1024 + (ob ^ (((ob >> 9) & 1) << 5)); }
__host__ __device__ __forceinline__ void stage_rc(int b, int& R, int& C) { const int st = b / 1024, sb = b % 1024, swz = sb ^ (((sb >> 9) & 1) << 5); R = (st >> 1) * 16 + swz / 64; C = (st & 1) * 32 + (swz % 64) / 2; }
__host__ __device__ __forceinline__ int perm32(int rho) { const int n = rho >> 4, i = rho & 15; return 8 * (i >> 2) + 4 * n + (i & 3); }
struct Unit { int pm, pn; };
struct Gemm { const bf16_t* A; const bf16_t* Bt; int K, lda, ldb; };
struct TileOrder {
    int nM, nN, nwg, G, c, lat_only;
    __device__ void init(int nM_, int nN_, int G_, int c_, int lat_only_) { nM = nM_; nN = nN_; nwg = nM * nN; G = G_; c = c_; lat_only = lat_only_; }
    __device__ bool next(int i, Unit& u) const {
        const long L = (long)i * G + c; if (L >= nwg) return false;
        int wgid = (int)L; { const int q = nwg / NXCD, r = nwg % NXCD, xcd = wgid % NXCD, off = wgid / NXCD; wgid = (xcd < r ? xcd * (q + 1) : r * (q + 1) + (xcd - r) * q) + off; }
        const int nig = WGM * nN, gid = wgid / nig, fm = gid * WGM, gsz = (nM - fm) < WGM ? (nM - fm) : WGM;
        u.pm = fm + ((wgid % nig) % gsz); u.pn = (wgid % nig) / gsz;
        if (lat_only) u.pm += u.pm >> 4;
        return true;
    }
    __device__ __forceinline__ void a_ready(const Unit&) const {}
    __device__ __forceinline__ void done(const Unit&) const {}
};

template <class Epi, class Sched>
__device__ __forceinline__ void gemm_phase(PG8_LAS unsigned char* lds, const Gemm g, const Sched& S, const Epi& E, const int g_wave) {
    int tid_ = MYTID; asm volatile("" : "+v"(tid_));
    const int tid = tid_, wid = __builtin_amdgcn_readfirstlane(tid >> 6), lane = tid & 63, wr = wid >> 2, wc = wid & 3, fr = lane & 15, fq = lane >> 4;
    const int K = g.K, nt = K / BK, lda = g.lda, ldb = g.ldb;
    unsigned voffA[2], voffB[2];
#pragma unroll
    for (int i = 0; i < 2; ++i) { int R, C; stage_rc(tid * 16 + i * 8192, R, C); const int Rb = Epi::PERM ? ((R & ~31) + perm32(R & 31)) : R;
        voffA[i] = (unsigned)(R * lda + C) * 2u; voffB[i] = (unsigned)(Rb * ldb + C) * 2u; }
    const size_t kstep = (size_t)(BK * 2);
    const size_t hstepA = (size_t)HALF * lda * 2, hstepB = (size_t)HALF * ldb * 2;
    const size_t tstepA = 2 * hstepA, tstepB = 2 * hstepB;
    const unsigned ldsw = (unsigned)wid * 1024u;
    const int aoff = lds_byte(wr * 64 + fr, fq * 8), boff = lds_byte(wc * 32 + fr, fq * 8);
#define PG8_SA(b, h) (((b) * 2 + (h)) * HTB)
#define PG8_SB(b, h) ((4 + (b) * 2 + (h)) * HTB)
#define PG8_STAGE(bufoff, gbase, voff) do { _Pragma("unroll") for (int _i = 0; _i < 2; ++_i) \
        __builtin_amdgcn_global_load_lds((const unsigned*)((const char*)(gbase) + (voff)[_i]), (PG8_LAS unsigned*)(lds + (bufoff) + ldsw + _i * 8192), 16, 0, 0); } while (0)
#define PG8_LDA(dst, b, h) do { _Pragma("unroll") for (int m = 0; m < 4; ++m) _Pragma("unroll") for (int k = 0; k < 2; ++k) dst[m][k] = *(const PG8_LAS bf16x8*)(lds + PG8_SA(b, h) + aoff + m * 2048 + k * 1024); } while (0)
    unsigned bbase_ = (unsigned)(uintptr_t)(lds + 4 * HTB) + (unsigned)boff; asm volatile("" : "+v"(bbase_));
    const PG8_LAS unsigned char* const ldsB = (const PG8_LAS unsigned char*)(uintptr_t)bbase_;
#define PG8_LDB(dst, b, h) do { _Pragma("unroll") for (int n = 0; n < 2; ++n) _Pragma("unroll") for (int k = 0; k < 2; ++k) dst[n][k] = *(const PG8_LAS bf16x8*)(ldsB + ((b) * 2 + (h)) * HTB + n * 2048 + k * 1024); } while (0)
#define PG8_MMA(ai, bj, At, Bt) do { __builtin_amdgcn_s_setprio(1); _Pragma("unroll") for (int m = 0; m < 4; ++m) _Pragma("unroll") for (int n = 0; n < 2; ++n) _Pragma("unroll") for (int k = 0; k < 2; ++k) \
        acc[ai][bj][m][n] = __builtin_amdgcn_mfma_f32_16x16x32_bf16(Bt[n][k], At[m][k], acc[ai][bj][m][n], 0, 0, 0); __builtin_amdgcn_s_setprio(0); } while (0)
#define PG8_WAIT_V(n) asm volatile("s_waitcnt vmcnt(" #n ")" ::: "memory")
#define PG8_WAIT_L(n) asm volatile("s_waitcnt lgkmcnt(" #n ")" ::: "memory")
#define PG8_BAR __builtin_amdgcn_s_barrier()
#define PG8_SCHED __builtin_amdgcn_sched_barrier(0)
    Unit cur, nxt; int ui = 0;
    if (!S.next(0, cur)) return;
    f32x4 acc[2][2][4][2];
#pragma unroll
    for (int a = 0; a < 2; ++a)
#pragma unroll
        for (int b = 0; b < 2; ++b)
#pragma unroll
            for (int m = 0; m < 4; ++m)
#pragma unroll
                for (int n = 0; n < 2; ++n) acc[a][b][m][n] = (f32x4){0.f, 0.f, 0.f, 0.f};
    bf16x8 At[4][2], B0[2][2], B1[2][2];
    const char* cA = (const char*)g.A + (size_t)cur.pm * tstepA; const char* cB = (const char*)g.Bt + (size_t)cur.pn * tstepB;
    S.a_ready(cur);
    PG8_STAGE(PG8_SB(0, 0), cB, voffB); PG8_STAGE(PG8_SA(0, 0), cA, voffA); PG8_STAGE(PG8_SB(0, 1), cB + hstepB, voffB); PG8_STAGE(PG8_SA(0, 1), cA + hstepA, voffA);
    if (wr == 1) PG8_BAR;
    PG8_WAIT_V(4); PG8_BAR;
    PG8_STAGE(PG8_SB(1, 0), cB + kstep, voffB); PG8_STAGE(PG8_SA(1, 0), cA + kstep, voffA); PG8_STAGE(PG8_SB(1, 1), cB + hstepB + kstep, voffB);
    PG8_WAIT_V(6); PG8_BAR;
    for (;;) {
        const bool has_next = S.next(ui + 1, nxt);
        const char* nA = has_next ? (const char*)g.A + (size_t)nxt.pm * tstepA : cA; const char* nB = has_next ? (const char*)g.Bt + (size_t)nxt.pn * tstepB : cB;
        for (int t = 0; t < nt; t += 2) {
            const bool last = (t == nt - 2);
            const char* a1 = cA + (size_t)(t + 1) * kstep;
            const char* a2 = last ? nA : cA + (size_t)(t + 2) * kstep; const char* b2 = last ? nB : cB + (size_t)(t + 2) * kstep;
            const char* a3 = a2 + kstep; const char* b3 = b2 + kstep;
            if (last && has_next) S.a_ready(nxt);
            PG8_LDB(B0, 0, 0); PG8_SCHED; PG8_LDA(At, 0, 0); PG8_STAGE(PG8_SA(1, 1), a1 + hstepA, voffA);
            PG8_WAIT_L(8); PG8_BAR; PG8_WAIT_L(0); PG8_MMA(0, 0, At, B0); PG8_BAR; PG8_SCHED;
            PG8_LDB(B1, 0, 1); PG8_STAGE(PG8_SB(0, 0), b2, voffB);
            PG8_BAR; PG8_WAIT_L(0); PG8_MMA(0, 1, At, B1); PG8_BAR;
            PG8_LDA(At, 0, 1); PG8_STAGE(PG8_SA(0, 0), a2, voffA);
            PG8_BAR; PG8_WAIT_L(0); PG8_MMA(1, 0, At, B0); PG8_BAR; PG8_SCHED;
            PG8_STAGE(PG8_SB(0, 1), b2 + hstepB, voffB);
            PG8_WAIT_V(6); PG8_BAR; PG8_MMA(1, 1, At, B1); PG8_BAR;
            PG8_LDB(B0, 1, 0); PG8_SCHED; PG8_LDA(At, 1, 0); PG8_STAGE(PG8_SA(0, 1), a2 + hstepA, voffA);
            PG8_WAIT_L(8); PG8_BAR; PG8_WAIT_L(0); PG8_MMA(0, 0, At, B0); PG8_BAR; PG8_SCHED;
            PG8_LDB(B1, 1, 1); PG8_STAGE(PG8_SB(1, 0), b3, voffB);
            PG8_BAR; PG8_WAIT_L(0); PG8_MMA(0, 1, At, B1); PG8_BAR;
            PG8_LDA(At, 1, 1); PG8_STAGE(PG8_SA(1, 0), a3, voffA);
            PG8_BAR; PG8_WAIT_L(0); PG8_MMA(1, 0, At, B0); PG8_BAR; PG8_SCHED;
            PG8_STAGE(PG8_SB(1, 1), b3 + hstepB, voffB);
            PG8_WAIT_V(6); PG8_BAR; PG8_MMA(1, 1, At, B1); PG8_BAR;
        }
        if constexpr (!Epi::AFTER_DRAIN) { int le = lane; asm volatile("" : "+v"(le)); E(acc, cur, wr, wc, le & 15, le >> 4); S.done(cur); }
        if (!has_next) break;
#pragma unroll
        for (int a = 0; a < 2; ++a)
#pragma unroll
            for (int b = 0; b < 2; ++b)
#pragma unroll
                for (int m = 0; m < 4; ++m)
#pragma unroll
                    for (int n = 0; n < 2; ++n) acc[a][b][m][n] = (f32x4){0.f, 0.f, 0.f, 0.f};
        cur = nxt; cA = nA; cB = nB; ++ui;
    }
    PG8_WAIT_V(0);
    if (wr == 0) PG8_BAR;
    PG8_BAR;
    if constexpr (Epi::AFTER_DRAIN) { E.fused(acc, cur, wr, wc, fr, fq, lds, wid, lane); S.done(cur); }
#undef PG8_SA
#undef PG8_SB
#undef PG8_STAGE
#undef PG8_LDA
#undef PG8_LDB
#undef PG8_MMA
#undef PG8_WAIT_V
#undef PG8_WAIT_L
#undef PG8_BAR
#undef PG8_SCHED
}

struct EpiStoreBf16 {
    static constexpr bool PERM = true, AFTER_DRAIN = false;
    bf16_t* O; int ldc;
    __device__ __forceinline__ void operator()(const f32x4 (&acc)[2][2][4][2], const Unit& u, int wr, int wc, int fr, int fq) const {
        const int row0 = u.pm * BM + wr * 64 + fr, col0 = u.pn * BM + wc * 32 + 8 * fq;
#pragma unroll
        for (int ai = 0; ai < 2; ++ai)
#pragma unroll
            for (int m = 0; m < 4; ++m) {
                bf16_t* rowp = O + (size_t)(row0 + ai * HALF + m * 16) * ldc + col0;
#pragma unroll
                for (int bj = 0; bj < 2; ++bj) {
                    const f32x4 v0 = acc[ai][bj][m][0], v1 = acc[ai][bj][m][1];
                    u32x4 w; w.x = cvt_pk_bf16(v0[0], v0[1]); w.y = cvt_pk_bf16(v0[2], v0[3]); w.z = cvt_pk_bf16(v1[0], v1[1]); w.w = cvt_pk_bf16(v1[2], v1[3]);
                    *(u32x4*)(rowp + bj * HALF) = w;
                }
            }
    }
};

__device__ __forceinline__ void cvt_table_bf16(const float* __restrict__ src, bf16_t* __restrict__ dst, size_t n8, const int g_wave) {
    const size_t stride = (size_t)gridDim.x * 512;
    for (size_t i = (size_t)blockIdx.x * 512 + MYTID; i < n8; i += stride) {
        const f32x4 a = *(const f32x4*)(src + i * 8), b = *(const f32x4*)(src + i * 8 + 4);
        u32x4 w; w.x = cvt_pk_bf16(a[0], a[1]); w.y = cvt_pk_bf16(a[2], a[3]); w.z = cvt_pk_bf16(b[0], b[1]); w.w = cvt_pk_bf16(b[2], b[3]);
        *(u32x4*)(dst + i * 8) = w;
    }
}

template <int MODE>
__device__ __forceinline__ void transpose_task(const float* __restrict__ W, int ldw, int K, int Nvalid, int Npad, const float* __restrict__ rs,
                                               bf16_t* __restrict__ Wt, float* tile, int rot, const int g_wave) {
    const int tk = K / 64, tn = Npad / 64, nt = tk * tn, tid = MYTID, G = gridDim.x;
    const int start = (int)((blockIdx.x + (unsigned)rot) % (unsigned)G);
    for (int u = start; u < nt; u += G) {
        const int k0 = (u % tk) * 64, n0 = (u / tk) * 64;
        __syncthreads();
#pragma unroll
        for (int i = 0; i < 8; ++i) {
            const int kk = (tid >> 6) + 8 * i, nn = tid & 63, n = n0 + nn;
            float v = 0.f;
            if (n < Nvalid) {
                const int col = (MODE == 0) ? n : ((n >> 6) * 128 + (MODE == 2 ? 64 : 0) + (n & 63));
                v = W[(size_t)(k0 + kk) * ldw + col];
                if (rs) v *= rs[k0 + kk];
            }
            tile[kk * 65 + nn] = v;
        }
        __syncthreads();
        {
            const int nn = tid >> 3, kc = (tid & 7) * 8;
            float v[8];
#pragma unroll
            for (int e = 0; e < 8; ++e) v[e] = tile[(kc + e) * 65 + nn];
            u32x4 w; w.x = cvt_pk_bf16(v[0], v[1]); w.y = cvt_pk_bf16(v[2], v[3]); w.z = cvt_pk_bf16(v[4], v[5]); w.w = cvt_pk_bf16(v[6], v[7]);
            *(u32x4*)(Wt + (size_t)(n0 + nn) * K + k0 + kc) = w;
        }
    }
}

template <bool SIGNED> __device__ __forceinline__ void cvt_table_i8(const float* __restrict__ src, unsigned char* __restrict__ dst, float* __restrict__ scales, int nrows, const int g_wave);
__device__ __forceinline__ void ph_filt_mlp(const MP& p, unsigned char* smem, const int g_wave);
__device__ __forceinline__ void ph_prep(const MP& p, unsigned char* smem, const int g_wave) {
    const int tid = MYTID, bid = blockIdx.x, G = gridDim.x;
    unsigned char* ws = p.ws;
    if (bid < 192) {
        float* sc = (float*)smem;
        float* red = (float*)(smem + 36864);
        const float* c = p.in[1]; const float* c_ctx = p.in[3]; const float* mod_w = p.in[4]; const float* mod_b = p.in[5];
        float* modv = (float*)(ws + WS_MODV);
        for (int e = tid; e < 9 * 1024; e += 512) {
            const int r = e >> 10, k = e & 1023;
            const float v = (r < 8) ? c[r * 1024 + k] : c_ctx[k];
            sc[e] = v / (1.f + __expf(-v));
        }
        __syncthreads();
        for (int u = bid; u < 192; u += G) {
            const int i = u / 96, j0 = (u % 96) * 64, col = tid & 63, kg = tid >> 6;
            float acc[9];
#pragma unroll
            for (int r = 0; r < 9; ++r) acc[r] = 0.f;
            const float* wp = mod_w + ((size_t)i * 1024 + kg * 128) * 6144 + j0 + col;
#pragma unroll 4
            for (int k = 0; k < 128; ++k) {
                const float w = wp[(size_t)k * 6144];
#pragma unroll
                for (int r = 0; r < 9; ++r) acc[r] += sc[r * 1024 + kg * 128 + k] * w;
            }
#pragma unroll
            for (int r = 0; r < 9; ++r) red[(kg * 9 + r) * 64 + col] = acc[r];
            __syncthreads();
            for (int e = tid; e < 9 * 64; e += 512) {
                const int r = e >> 6, cc = e & 63;
                float s = 0.f;
#pragma unroll
                for (int g8 = 0; g8 < 8; ++g8) s += red[(g8 * 9 + r) * 64 + cc];
                modv[((size_t)i * 9 + r) * 6144 + j0 + cc] = s + mod_b[i * 6144 + j0 + cc];
            }
            __syncthreads();
        }
    }
    __syncthreads();
    float* tile = (float*)smem;
    transpose_task<0>(p.in[9], DLAT, 1024, DLAT, 768, nullptr, (bf16_t*)(ws + WS_WDKV), tile, 64, g_wave);
    transpose_task<0>(p.in[11], 1536, QLORA, 1536, 1536, p.in[10], (bf16_t*)(ws + WS_WUQ), tile, 0, g_wave);
    transpose_task<1>(p.in[13], 2048, KVLORA, 1024, 1024, p.in[12], (bf16_t*)(ws + WS_WK), tile, 144, g_wave);
    transpose_task<2>(p.in[13], 2048, KVLORA, 1024, 1024, p.in[12], (bf16_t*)(ws + WS_WV), tile, 208, g_wave);
    transpose_task<0>(p.in[14], 1024, 1024, 1024, 1024, nullptr, (bf16_t*)(ws + WS_WO), tile, 16, g_wave);
    transpose_task<0>(p.in[29], 2048, 1024, 2048, 2048, nullptr, (bf16_t*)(ws + WS_WQ), tile, 32, g_wave);
    transpose_task<0>(p.in[29] + (size_t)1024 * 2048, 2048, 1024, 2048, 2048, nullptr, (bf16_t*)(ws + WS_WQ) + (size_t)2048 * 1024, tile, 96, g_wave);
    transpose_task<0>(p.in[15], 3072, 1024, 3072, 3072, nullptr, (bf16_t*)(ws + WS_WIN), tile, 160, g_wave);
    transpose_task<0>(p.in[28], 1024, 1024, 1024, 1024, nullptr, (bf16_t*)(ws + WS_WOUT), tile, 224, g_wave);
    cvt_table_bf16(p.in[30], (bf16_t*)(ws + WS_KEYS), (size_t)2 * 16 * 128 * 128 / 8, g_wave);
    for (int L = 0; L < 2; ++L) {
        cvt_table_i8<true>(p.in[31] + (size_t)L * 16384 * 1024, ws + WS_PT + (size_t)L * 32 * MiB, (float*)(ws + WS_PSC) + L * 32768, 16384, g_wave);
        cvt_table_i8<false>(p.in[32] + (size_t)L * 16384 * 1024, ws + WS_PT + (size_t)L * 32 * MiB + 16 * MiB, (float*)(ws + WS_PSC) + L * 32768 + 16384, 16384, g_wave);
    }
    {
        float* rope = (float*)(ws + WS_ROPE);
        for (int e = bid * 512 + tid; e < 4096 * 16; e += G * 512) {
            const int t = e >> 4, i = e & 15;
            const float inv = powf(10000.f, -(float)(i & 7) / 8.f);
            const float pos = (i < 8) ? (float)(t / 64) : (float)(t % 64);
            const float a = pos * inv;
            rope[t * 32 + i] = cosf(a);
            rope[t * 32 + 16 + i] = sinf(a);
        }
    }
    ph_filt_mlp(p, smem, g_wave);
    for (int e = bid * 512 + tid; e < 2048; e += G * 512) {
        ((float*)(ws + WS_FNORM))[e] = 0.f;
        ((bf16_t*)(ws + WS_FILT))[(size_t)e * 8192] = 0;
    }
}

template <int MODE>
__device__ __forceinline__ void ph_normmod(const float* __restrict__ xlat, const float* __restrict__ xctx, const float* __restrict__ g,
                                           const float* __restrict__ modl  , int shift_chunk, bf16_t* __restrict__ Hb, const int g_wave) {
    const int lane = lane_id(), wid = g_wave;
    const int nrows = (MODE == 0) ? NROW : NTOK;
    for (int row = blockIdx.x * 8 + wid; row < nrows; row += gridDim.x * 8) {
        const float* src; int mr;
        if (MODE == 0) {
            const int b = row / RPB, r = row - b * RPB;
            if (r < SEQ) { src = xlat + ((size_t)b * SEQ + r) * 1024; mr = b; }
            else { src = xctx + ((size_t)b * CTXL + (r - SEQ)) * 1024; mr = 8; }
        } else { src = nullptr; mr = row >> 12; }
        const float* shift = modl + (size_t)mr * 6144 + shift_chunk * 1024;
        const float* scale = shift + 1024;
        f32x4 v[4];
        float ss = 0.f;
#pragma unroll
        for (int c = 0; c < 4; ++c) {
            if (MODE == 0) v[c] = *(const f32x4*)(src + c * 256 + lane * 4);
            else { const u32x2 w = *(const u32x2*)((const bf16_t*)xlat + (size_t)row * 1024 + c * 256 + lane * 4); v[c] = (f32x4){bflo(w.x), bfhi(w.x), bflo(w.y), bfhi(w.y)}; }
            ss += v[c][0] * v[c][0] + v[c][1] * v[c][1] + v[c][2] * v[c][2] + v[c][3] * v[c][3];
        }
        ss = warp_sum(ss);
        const float rs = rsqrtf(ss * (1.f / 1024.f) + 1e-6f);
#pragma unroll
        for (int c = 0; c < 4; ++c) {
            const int j = c * 256 + lane * 4;
            const f32x4 gg = *(const f32x4*)(g + j), sh = *(const f32x4*)(shift + j), scl = *(const f32x4*)(scale + j);
            float y[4];
#pragma unroll
            for (int e = 0; e < 4; ++e) y[e] = v[c][e] * rs * gg[e] * (1.f + scl[e]) + sh[e];
            u32x2 w; w.x = cvt_pk_bf16(y[0], y[1]); w.y = cvt_pk_bf16(y[2], y[3]);
            *(u32x2*)(Hb + (size_t)row * 1024 + j) = w;
        }
    }
}

__device__ __forceinline__ void ph_latpost(const bf16_t* __restrict__ LATb, const float* __restrict__ rope, float* __restrict__ RQ,
                                           float* __restrict__ RK, bf16_t* __restrict__ KRb, const int g_wave) {
    const int lane = lane_id(), wid = g_wave;
    for (int row = blockIdx.x * 8 + wid; row < NROW; row += gridDim.x * 8) {
        const bf16_t* l = LATb + (size_t)row * 768;
        float sq = 0.f, sk = 0.f;
        if (lane < 48) {
            const u32x4 w = *(const u32x4*)(l + lane * 8);
#pragma unroll
            for (int e = 0; e < 4; ++e) { const float a = bflo(w[e]), b = bfhi(w[e]); sq += a * a + b * b; }
        }
        if (lane < 32) {
            const u32x4 w = *(const u32x4*)(l + QLORA + lane * 8);
#pragma unroll
            for (int e = 0; e < 4; ++e) { const float a = bflo(w[e]), b = bfhi(w[e]); sk += a * a + b * b; }
        }
        sq = warp_sum(sq); sk = warp_sum(sk);
        float xv[8];
        {
            const u32x4 w = *(const u32x4*)(l + 640 + (lane & 3) * 8);
#pragma unroll
            for (int e = 0; e < 4; ++e) { xv[2 * e] = bflo(w[e]); xv[2 * e + 1] = bfhi(w[e]); }
        }
        const int b = row / RPB, r = row - b * RPB;
        float ov[8];
        if (r < SEQ) {
            const float* cs = rope + (size_t)r * 32 + ((lane >> 1) & 1) * 8;
            const float sgn = (lane & 1) ? 1.f : -1.f;
#pragma unroll
            for (int j = 0; j < 8; ++j) {
                const float pv = __shfl_xor(xv[j], 1);
                ov[j] = xv[j] * cs[j] + sgn * pv * cs[16 + j];
            }
        } else {
#pragma unroll
            for (int j = 0; j < 8; ++j) ov[j] = xv[j];
        }
        if (lane < 4) {
            u32x4 w; w.x = cvt_pk_bf16(ov[0], ov[1]); w.y = cvt_pk_bf16(ov[2], ov[3]); w.z = cvt_pk_bf16(ov[4], ov[5]); w.w = cvt_pk_bf16(ov[6], ov[7]);
            *(u32x4*)(KRb + (size_t)row * 32 + lane * 8) = w;
        }
        if (lane == 0) { RQ[row] = rsqrtf(sq * (1.f / 384.f) + 1e-6f); RK[row] = rsqrtf(sk * (1.f / 256.f) + 1e-6f); }
    }
}

constexpr float QSCALE = 0.10206207261596575f * 1.4426950408889634f;
struct EpiQ {
    static constexpr bool PERM = true, AFTER_DRAIN = false;
    bf16_t* Qb; const float* RQ; const float* rope;
    __device__ __forceinline__ void operator()(const f32x4 (&acc)[2][2][4][2], const Unit& u, int wr, int wc, int fr, int fq) const {
        const int b = u.pm / 17, tt = (u.pm - b * 17) * BM + wr * 64 + fr;
        const float* rqp = RQ + (size_t)b * RPB + tt;
        bf16_t* qp = Qb + ((size_t)b * SEQ + tt) * 1536 + 8 * fq;
        const float* cs0 = rope + (size_t)tt * 32 + (fq >> 1) * 8;
        const float sgn = (fq & 1) ? 1.f : -1.f;
#pragma unroll
        for (int ai = 0; ai < 2; ++ai)
#pragma unroll
            for (int m = 0; m < 4; ++m) {
                const int dr = ai * HALF + m * 16;
                const float sc = rqp[dr] * QSCALE;
#pragma unroll
                for (int bj = 0; bj < 2; ++bj) {
                    const int g32 = u.pn * 8 + bj * 4 + wc;
                    float v[8];
#pragma unroll
                    for (int e = 0; e < 4; ++e) { v[e] = acc[ai][bj][m][0][e] * sc; v[4 + e] = acc[ai][bj][m][1][e] * sc; }
                    if (g32 % 3 == 2) {
                        const float* cs = cs0 + (size_t)dr * 32;
#pragma unroll
                        for (int j = 0; j < 8; ++j) {
                            const float pv = __shfl_xor(v[j], 16);
                            v[j] = v[j] * cs[j] + sgn * pv * cs[16 + j];
                        }
                    }
                    u32x4 w; w.x = cvt_pk_bf16(v[0], v[1]); w.y = cvt_pk_bf16(v[2], v[3]); w.z = cvt_pk_bf16(v[4], v[5]); w.w = cvt_pk_bf16(v[6], v[7]);
                    *(u32x4*)(qp + (size_t)dr * 1536 + g32 * 32) = w;
                }
            }
    }
};
struct EpiRowScale {
    static constexpr bool PERM = true, AFTER_DRAIN = false;
    bf16_t* O; int ldc; const float* rs;
    __device__ __forceinline__ void operator()(const f32x4 (&acc)[2][2][4][2], const Unit& u, int wr, int wc, int fr, int fq) const {
        const int row0 = u.pm * BM + wr * 64 + fr, col0 = u.pn * BM + wc * 32 + 8 * fq;
#pragma unroll
        for (int ai = 0; ai < 2; ++ai)
#pragma unroll
            for (int m = 0; m < 4; ++m) {
                const int row = row0 + ai * HALF + m * 16;
                const float sc = rs[row];
                bf16_t* rowp = O + (size_t)row * ldc + col0;
#pragma unroll
                for (int bj = 0; bj < 2; ++bj) {
                    const f32x4 v0 = acc[ai][bj][m][0] * sc, v1 = acc[ai][bj][m][1] * sc;
                    u32x4 w; w.x = cvt_pk_bf16(v0[0], v0[1]); w.y = cvt_pk_bf16(v0[2], v0[3]); w.z = cvt_pk_bf16(v1[0], v1[1]); w.w = cvt_pk_bf16(v1[2], v1[3]);
                    *(u32x4*)(rowp + bj * HALF) = w;
                }
            }
    }
};
struct EpiColScale {
    static constexpr bool PERM = true, AFTER_DRAIN = false;
    bf16_t* O; int ldc; const float* cs;
    __device__ __forceinline__ void operator()(const f32x4 (&acc)[2][2][4][2], const Unit& u, int wr, int wc, int fr, int fq) const {
        const int row0 = u.pm * BM + wr * 64 + fr, col0 = u.pn * BM + wc * 32 + 8 * fq;
#pragma unroll
        for (int bj = 0; bj < 2; ++bj) {
            const f32x4 s0 = *(const f32x4*)(cs + col0 + bj * HALF), s1 = *(const f32x4*)(cs + col0 + bj * HALF + 4);
            bf16_t* colp = O + (size_t)row0 * ldc + col0 + bj * HALF;
#pragma unroll
            for (int ai = 0; ai < 2; ++ai)
#pragma unroll
                for (int m = 0; m < 4; ++m) {
                    const f32x4 v0 = acc[ai][bj][m][0] * s0, v1 = acc[ai][bj][m][1] * s1;
                    u32x4 w; w.x = cvt_pk_bf16(v0[0], v0[1]); w.y = cvt_pk_bf16(v0[2], v0[3]); w.z = cvt_pk_bf16(v1[0], v1[1]); w.w = cvt_pk_bf16(v1[2], v1[3]);
                    *(u32x4*)(colp + (size_t)(ai * HALF + m * 16) * ldc) = w;
                }
        }
    }
};
template <bool XIN_F32> struct EpiResid {
    static constexpr bool PERM = false, AFTER_DRAIN = false;
    bf16_t* Xo; const void* xin; const float* gate;
    __device__ __forceinline__ void operator()(const f32x4 (&acc)[2][2][4][2], const Unit& u, int wr, int wc, int fr, int fq) const {
        const int row0 = u.pm * BM + wr * 64 + fr, col0 = u.pn * BM + wc * 32 + 4 * fq;
        const float* gp = gate + (size_t)(row0 >> 12) * 6144 + col0;
        f32x4 gv[2][2];
#pragma unroll
        for (int bj = 0; bj < 2; ++bj)
#pragma unroll
            for (int n = 0; n < 2; ++n) gv[bj][n] = *(const f32x4*)(gp + bj * HALF + n * 16);
#pragma unroll
        for (int ai = 0; ai < 2; ++ai)
#pragma unroll
            for (int m = 0; m < 4; ++m) {
                const size_t ro = (size_t)(row0 + ai * HALF + m * 16) * 1024 + col0;
#pragma unroll
                for (int bj = 0; bj < 2; ++bj)
#pragma unroll
                    for (int n = 0; n < 2; ++n) {
                        f32x4 xv;
                        if (XIN_F32) xv = *(const f32x4*)((const float*)xin + ro + bj * HALF + n * 16);
                        else { const u32x2 w = *(const u32x2*)((const bf16_t*)xin + ro + bj * HALF + n * 16); xv = (f32x4){bflo(w.x), bfhi(w.x), bflo(w.y), bfhi(w.y)}; }
                        const f32x4 o = xv + gv[bj][n] * acc[ai][bj][m][n];
                        u32x2 ow; ow.x = cvt_pk_bf16(o[0], o[1]); ow.y = cvt_pk_bf16(o[2], o[3]);
                        *(u32x2*)(Xo + ro + bj * HALF + n * 16) = ow;
                    }
            }
    }
};

constexpr int AT_KSTR = 208, AT_VSTR = 144, AT_KBYTES = 64 * AT_KSTR, AT_BUF = 64 * AT_KSTR + 64 * AT_VSTR;
constexpr int AT_NT = RPB / 64;
struct AtStage { u32x4 k, v, r; };
__device__ __forceinline__ void at_pair(const unsigned char* kbA, const unsigned char* kbB, const bf16x8 (&qf)[6], int r, int hh, f32x16& o0, f32x16& o1, float& mrun, float& lrun, const bool first) {
    const unsigned char* vbA = kbA + AT_KBYTES; const unsigned char* vbB = kbB + AT_KBYTES;
    f32x16 a0, a1;
    {
        const float nm = -mrun;
#pragma unroll
        for (int e = 0; e < 16; ++e) { a0[e] = nm; a1[e] = nm; }
    }
#pragma unroll
    for (int ks = 0; ks < 6; ++ks) {
        const bf16x8 ka = *(const bf16x8*)(kbA + r * AT_KSTR + ks * 32 + hh * 16), kb2 = *(const bf16x8*)(kbA + (32 + r) * AT_KSTR + ks * 32 + hh * 16);
        a0 = __builtin_amdgcn_mfma_f32_32x32x16_bf16(ka, qf[ks], a0, 0, 0, 0);
        a1 = __builtin_amdgcn_mfma_f32_32x32x16_bf16(kb2, qf[ks], a1, 0, 0, 0);
    }
    {
        float mx = a0[0];
#pragma unroll
        for (int e = 1; e < 16; ++e) mx = fmaxf(mx, a0[e]);
#pragma unroll
        for (int e = 0; e < 16; ++e) mx = fmaxf(mx, a1[e]);
        mx = fmaxf(mx, __shfl_xor(mx, 32));
        if (first || !__all(mx <= 8.f)) {
            const float dm = first ? mx : fmaxf(mx, 0.f);
            const float alpha = first ? 1.f : __builtin_amdgcn_exp2f(-dm);
            mrun += dm; lrun *= alpha;
#pragma unroll
            for (int e = 0; e < 16; ++e) { o0[e] *= alpha; o1[e] *= alpha; a0[e] -= dm; a1[e] -= dm; }
        }
    }
    f32x16 b0, b1;
    {
        const float nm = -mrun;
#pragma unroll
        for (int e = 0; e < 16; ++e) { b0[e] = nm; b1[e] = nm; }
    }
#pragma unroll
    for (int ks = 0; ks < 6; ++ks) {
        const bf16x8 ka = *(const bf16x8*)(kbB + r * AT_KSTR + ks * 32 + hh * 16), kb2 = *(const bf16x8*)(kbB + (32 + r) * AT_KSTR + ks * 32 + hh * 16);
        b0 = __builtin_amdgcn_mfma_f32_32x32x16_bf16(ka, qf[ks], b0, 0, 0, 0);
        b1 = __builtin_amdgcn_mfma_f32_32x32x16_bf16(kb2, qf[ks], b1, 0, 0, 0);
    }
    bf16x8 pb[4];
    {
        float ps = 0.f;
#pragma unroll
        for (int e = 0; e < 16; ++e) { a0[e] = __builtin_amdgcn_exp2f(a0[e]); ps += a0[e]; }
#pragma unroll
        for (int e = 0; e < 16; ++e) { a1[e] = __builtin_amdgcn_exp2f(a1[e]); ps += a1[e]; }
#pragma unroll
        for (int s = 0; s < 2; ++s) {
            u32x4 w0, w1;
            w0.x = cvt_pk_bf16(a0[8 * s + 0], a0[8 * s + 1]); w0.y = cvt_pk_bf16(a0[8 * s + 2], a0[8 * s + 3]);
            w0.z = cvt_pk_bf16(a0[8 * s + 4], a0[8 * s + 5]); w0.w = cvt_pk_bf16(a0[8 * s + 6], a0[8 * s + 7]);
            w1.x = cvt_pk_bf16(a1[8 * s + 0], a1[8 * s + 1]); w1.y = cvt_pk_bf16(a1[8 * s + 2], a1[8 * s + 3]);
            w1.z = cvt_pk_bf16(a1[8 * s + 4], a1[8 * s + 5]); w1.w = cvt_pk_bf16(a1[8 * s + 6], a1[8 * s + 7]);
            pb[s] = __builtin_bit_cast(bf16x8, w0); pb[2 + s] = __builtin_bit_cast(bf16x8, w1);
        }
        lrun += ps;
    }
#pragma unroll
    for (int ks = 0; ks < 4; ++ks) {
        const bf16x8 va = *(const bf16x8*)(vbA + r * AT_VSTR + ks * 32 + hh * 16), vb2 = *(const bf16x8*)(vbA + (32 + r) * AT_VSTR + ks * 32 + hh * 16);
        o0 = __builtin_amdgcn_mfma_f32_32x32x16_bf16(va, pb[ks], o0, 0, 0, 0);
        o1 = __builtin_amdgcn_mfma_f32_32x32x16_bf16(vb2, pb[ks], o1, 0, 0, 0);
    }
    {
        float mx = b0[0];
#pragma unroll
        for (int e = 1; e < 16; ++e) mx = fmaxf(mx, b0[e]);
#pragma unroll
        for (int e = 0; e < 16; ++e) mx = fmaxf(mx, b1[e]);
        mx = fmaxf(mx, __shfl_xor(mx, 32));
        if (!__all(mx <= 8.f)) {
            const float dm = fmaxf(mx, 0.f);
            const float alpha = __builtin_amdgcn_exp2f(-dm);
            mrun += dm; lrun *= alpha;
#pragma unroll
            for (int e = 0; e < 16; ++e) { o0[e] *= alpha; o1[e] *= alpha; b0[e] -= dm; b1[e] -= dm; }
        }
    }
    {
        float ps = 0.f;
#pragma unroll
        for (int e = 0; e < 16; ++e) { b0[e] = __builtin_amdgcn_exp2f(b0[e]); ps += b0[e]; }
#pragma unroll
        for (int e = 0; e < 16; ++e) { b1[e] = __builtin_amdgcn_exp2f(b1[e]); ps += b1[e]; }
#pragma unroll
        for (int s = 0; s < 2; ++s) {
            u32x4 w0, w1;
            w0.x = cvt_pk_bf16(b0[8 * s + 0], b0[8 * s + 1]); w0.y = cvt_pk_bf16(b0[8 * s + 2], b0[8 * s + 3]);
            w0.z = cvt_pk_bf16(b0[8 * s + 4], b0[8 * s + 5]); w0.w = cvt_pk_bf16(b0[8 * s + 6], b0[8 * s + 7]);
            w1.x = cvt_pk_bf16(b1[8 * s + 0], b1[8 * s + 1]); w1.y = cvt_pk_bf16(b1[8 * s + 2], b1[8 * s + 3]);
            w1.z = cvt_pk_bf16(b1[8 * s + 4], b1[8 * s + 5]); w1.w = cvt_pk_bf16(b1[8 * s + 6], b1[8 * s + 7]);
            pb[s] = __builtin_bit_cast(bf16x8, w0); pb[2 + s] = __builtin_bit_cast(bf16x8, w1);
        }
        lrun += ps;
    }
#pragma unroll
    for (int ks = 0; ks < 4; ++ks) {
        const bf16x8 va = *(const bf16x8*)(vbB + r * AT_VSTR + ks * 32 + hh * 16), vb2 = *(const bf16x8*)(vbB + (32 + r) * AT_VSTR + ks * 32 + hh * 16);
        o0 = __builtin_amdgcn_mfma_f32_32x32x16_bf16(va, pb[ks], o0, 0, 0, 0);
        o1 = __builtin_amdgcn_mfma_f32_32x32x16_bf16(vb2, pb[ks], o1, 0, 0, 0);
    }
}
__device__ __forceinline__ void ph_attn(const bf16_t* __restrict__ Qb, const bf16_t* __restrict__ Kb, const bf16_t* __restrict__ KRb,
                                        const bf16_t* __restrict__ VT, bf16_t* __restrict__ Ob, unsigned char* smem, const int g_wave) {
    const int tid = MYTID, lane = tid & 63, wid = g_wave, r = lane & 31, hh = lane >> 5;
    const int bid = blockIdx.x, xcd = bid & 7, local = bid >> 3;
    const int skey = tid >> 3, sch = tid & 7;
    const int rkey = tid >> 2, rch = tid & 3;
    const bool rk = tid < 256;
    const int vslot0 = ((sch & 1) ? 1 : 0), vslot1 = ((sch & 1) ? 3 : 2);
    const int koff = skey * AT_KSTR + sch * 16, kroff = rkey * AT_KSTR + 128 + rch * 16;
    const int voff0 = AT_KBYTES + skey * AT_VSTR + (sch >> 1) * 32 + vslot0 * 8, voff1 = AT_KBYTES + skey * AT_VSTR + (sch >> 1) * 32 + vslot1 * 8;
#define AT_LOAD(S, t) do { (S).k = *(const u32x4*)(kbase + (size_t)(t) * 64 * 1024); (S).v = *(const u32x4*)(vbase + (t) * 64); \
                           if (rk) (S).r = *(const u32x4*)(krbase + (size_t)(t) * 64 * 32); } while (0)
#define AT_WRITE(S, buf) do { unsigned char* _b = smem + (buf) * AT_BUF; *(u32x4*)(_b + koff) = (S).k; if (rk) *(u32x4*)(_b + kroff) = (S).r; \
                              *(u32x2*)(_b + voff0) = (u32x2){(S).v.x, (S).v.y}; *(u32x2*)(_b + voff1) = (u32x2){(S).v.z, (S).v.w}; } while (0)
    for (int i = 0; i < 8; ++i) {
        const int bh = i * 16 + xcd * 2 + (local >> 4), qblk = local & 15;
        const int b = bh >> 4, h = bh & 15;
        const int t0 = qblk * 256 + wid * 32;
        bf16x8 qf[6];
        {
            const bf16_t* qp = Qb + ((size_t)b * SEQ + t0 + r) * 1536 + h * 96 + hh * 8;
#pragma unroll
            for (int ks = 0; ks < 6; ++ks) qf[ks] = *(const bf16x8*)(qp + ks * 16);
        }
        const bf16_t* kbase = Kb + ((size_t)b * RPB + skey) * 1024 + h * 64 + sch * 8;
        const bf16_t* krbase = KRb + ((size_t)b * RPB + rkey) * 32 + rch * 8;
        const bf16_t* vbase = VT + ((size_t)h * 64 + skey) * NROW + (size_t)b * RPB + sch * 8;
        AtStage SA, SB;
        AT_LOAD(SA, 0);
        AT_LOAD(SB, 1);
        AT_WRITE(SA, 0);
        AT_WRITE(SB, 1);
        __syncthreads();
        f32x16 o0 = {}, o1 = {};
        float mrun = 0.f, lrun = 0.f;
        for (int kt = 0; kt < AT_NT; kt += 2) {
            const bool more = (kt + 2 < AT_NT);
            if (more) { AT_LOAD(SA, kt + 2); AT_LOAD(SB, kt + 3); }
            at_pair(smem + (kt & 3) * AT_BUF, smem + ((kt + 1) & 3) * AT_BUF, qf, r, hh, o0, o1, mrun, lrun, kt == 0);
            if (more) { AT_WRITE(SA, (kt + 2) & 3); AT_WRITE(SB, (kt + 3) & 3); }
            __syncthreads();
        }
        const float ltot = lrun + __shfl_xor(lrun, 32);
        const float inv = 1.f / ltot;
        bf16_t* op = Ob + ((size_t)b * SEQ + t0 + r) * 1024 + h * 64 + 4 * hh;
#pragma unroll
        for (int g4 = 0; g4 < 4; ++g4) {
            u32x2 w0, w1;
            w0.x = cvt_pk_bf16(o0[4 * g4 + 0] * inv, o0[4 * g4 + 1] * inv); w0.y = cvt_pk_bf16(o0[4 * g4 + 2] * inv, o0[4 * g4 + 3] * inv);
            w1.x = cvt_pk_bf16(o1[4 * g4 + 0] * inv, o1[4 * g4 + 1] * inv); w1.y = cvt_pk_bf16(o1[4 * g4 + 2] * inv, o1[4 * g4 + 3] * inv);
            *(u32x2*)(op + 8 * g4) = w0;
            *(u32x2*)(op + 32 + 8 * g4) = w1;
        }
    }
#undef AT_LOAD
#undef AT_WRITE
}

template <int LB> __device__ __forceinline__ unsigned mk_key(float s, unsigned payload) {
    const unsigned u = __float_as_uint(s);
    const unsigned o = (u & 0x80000000u) ? ~u : (u | 0x80000000u);
    return (o & ~((1u << LB) - 1u)) | (((1u << LB) - 1u) - payload);
}
template <int LB> __device__ __forceinline__ float key_val(unsigned k) {
    const unsigned o = k & ~((1u << LB) - 1u);
    const unsigned u = (o & 0x80000000u) ? (o & 0x7fffffffu) : ~o;
    return __uint_as_float(u);
}
template <int LB> __device__ __forceinline__ unsigned key_payload(unsigned k) { return ((1u << LB) - 1u) - (k & ((1u << LB) - 1u)); }
#define CMPEX_D(a, b) do { const unsigned _x = (a), _y = (b); (a) = _x > _y ? _x : _y; (b) = _x > _y ? _y : _x; } while (0)
__device__ __forceinline__ void sort16_desc(unsigned (&a)[16]) {
#pragma unroll
    for (int k = 2; k <= 16; k <<= 1)
#pragma unroll
        for (int j = k >> 1; j > 0; j >>= 1)
#pragma unroll
            for (int i = 0; i < 16; ++i) {
                const int l = i ^ j;
                if (l > i) {
                    if ((i & k) == 0) CMPEX_D(a[i], a[l]);
                    else CMPEX_D(a[l], a[i]);
                }
            }
}
__device__ __forceinline__ void merge16_desc(unsigned (&run)[16], const unsigned (&b)[16]) {
#pragma unroll
    for (int i = 0; i < 16; ++i) run[i] = run[i] > b[15 - i] ? run[i] : b[15 - i];
#pragma unroll
    for (int j = 8; j > 0; j >>= 1)
#pragma unroll
        for (int i = 0; i < 16; ++i) {
            const int l = i ^ j;
            if (l > i) CMPEX_D(run[i], run[l]);
        }
}

__device__ __forceinline__ void route_list(const bf16_t* __restrict__ PQ, const bf16_t* __restrict__ KEYS, int t0, int hp, int r, int hh, unsigned (&run)[16]) {
    bf16x8 qf[8];
    {
        const bf16_t* qp = PQ + (size_t)(t0 + r) * 2048 + hp * 128 + hh * 8;
#pragma unroll
        for (int ks = 0; ks < 8; ++ks) qf[ks] = *(const bf16x8*)(qp + ks * 16);
    }
    const bf16_t* kp = KEYS + ((size_t)hp * 128 + r) * 128 + hh * 8;
#pragma unroll
    for (int e = 0; e < 16; ++e) run[e] = 0u;
    bf16x8 kf[8];
#pragma unroll
    for (int ks = 0; ks < 8; ++ks) kf[ks] = *(const bf16x8*)(kp + ks * 16);
#pragma unroll 1
    for (int mt = 0; mt < 4; ++mt) {
        f32x16 s = {};
#pragma unroll
        for (int ks = 0; ks < 8; ++ks) s = __builtin_amdgcn_mfma_f32_32x32x16_bf16(kf[ks], qf[ks], s, 0, 0, 0);
        {
            const bf16_t* kn = kp + (size_t)((mt + 1) & 3) * 32 * 128;
#pragma unroll
            for (int ks = 0; ks < 8; ++ks) kf[ks] = *(const bf16x8*)(kn + ks * 16);
        }
        unsigned cur[16];
#pragma unroll
        for (int e = 0; e < 16; ++e) {
            const unsigned n = (unsigned)(32 * mt + (e & 3) + 8 * (e >> 2) + 4 * hh);
            cur[e] = mk_key<7>(s[e], n);
        }
        sort16_desc(cur);
        merge16_desc(run, cur);
    }
    unsigned oth[16];
#pragma unroll
    for (int e = 0; e < 16; ++e) oth[e] = (unsigned)__shfl_xor((int)run[e], 32);
    merge16_desc(run, oth);
}

__device__ __forceinline__ void ph_route(const bf16_t* __restrict__ PQ, const bf16_t* __restrict__ KEYS, int* __restrict__ EIDX,
                                         float* __restrict__ GW, unsigned char* smem, const int g_wave) {
    const int lane = lane_id(), r = lane & 31, hh = lane >> 5, wid = g_wave;
    unsigned* ibuf = (unsigned*)(smem + wid * 2048);
    for (int task = blockIdx.x * 8 + wid; task < (NTOK / 32) * 4; task += gridDim.x * 8) {
        const int tg = task >> 2, hp2 = task & 3, t0 = tg * 32;
        unsigned L0[16], L1[16], L2[16], L3[16];
        route_list(PQ, KEYS, t0, hp2 * 4 + 0, r, hh, L0); __builtin_amdgcn_sched_barrier(0);
        route_list(PQ, KEYS, t0, hp2 * 4 + 1, r, hh, L1); __builtin_amdgcn_sched_barrier(0);
        route_list(PQ, KEYS, t0, hp2 * 4 + 2, r, hh, L2); __builtin_amdgcn_sched_barrier(0);
        route_list(PQ, KEYS, t0, hp2 * 4 + 3, r, hh, L3); __builtin_amdgcn_sched_barrier(0);
        unsigned A[16], B[16];
#pragma unroll
        for (int e = 0; e < 16; ++e) { A[e] = hh ? L2[e] : L0[e]; B[e] = hh ? L3[e] : L1[e]; }
#pragma unroll
        for (int j = 0; j < 4; ++j) {
            unsigned wa = 0, wb = 0;
#pragma unroll
            for (int q = 0; q < 4; ++q) { wa |= key_payload<7>(A[4 * j + q]) << (8 * q); wb |= key_payload<7>(B[4 * j + q]) << (8 * q); }
            ibuf[j * 64 + lane] = wa; ibuf[(4 + j) * 64 + lane] = wb;
        }
        float va[16], vb[16];
#pragma unroll
        for (int e = 0; e < 16; ++e) { va[e] = key_val<7>(A[e]); vb[e] = key_val<7>(B[e]); }
#define CAND(k, i, j) grp[k] = mk_key<8>(va[i] + vb[j], (unsigned)((i) * 16 + (j)))
        unsigned fin[16], grp[16];
        CAND(0, 0, 0); CAND(1, 0, 1); CAND(2, 0, 2); CAND(3, 0, 3); CAND(4, 0, 4); CAND(5, 0, 5); CAND(6, 0, 6); CAND(7, 0, 7); CAND(8, 0, 8); CAND(9, 0, 9); CAND(10, 0, 10); CAND(11, 0, 11); CAND(12, 0, 12); CAND(13, 0, 13); CAND(14, 0, 14); CAND(15, 0, 15);
        sort16_desc(grp);
#pragma unroll
        for (int e = 0; e < 16; ++e) fin[e] = grp[e];
        CAND(0, 1, 0); CAND(1, 1, 1); CAND(2, 1, 2); CAND(3, 1, 3); CAND(4, 1, 4); CAND(5, 1, 5); CAND(6, 1, 6); CAND(7, 1, 7); CAND(8, 2, 0); CAND(9, 2, 1); CAND(10, 2, 2); CAND(11, 2, 3); CAND(12, 2, 4); CAND(13, 3, 0); CAND(14, 3, 1); CAND(15, 3, 2);
        sort16_desc(grp);
        merge16_desc(fin, grp);
        CAND(0, 3, 3); CAND(1, 4, 0); CAND(2, 4, 1); CAND(3, 4, 2); CAND(4, 5, 0); CAND(5, 5, 1); CAND(6, 6, 0); CAND(7, 6, 1); CAND(8, 7, 0); CAND(9, 7, 1); CAND(10, 8, 0); CAND(11, 9, 0); CAND(12, 10, 0); CAND(13, 11, 0); CAND(14, 12, 0); CAND(15, 13, 0);
        sort16_desc(grp);
        merge16_desc(fin, grp);
        CAND(0, 14, 0); CAND(1, 15, 0);
        grp[2] = 0u; grp[3] = 0u; grp[4] = 0u; grp[5] = 0u; grp[6] = 0u; grp[7] = 0u; grp[8] = 0u; grp[9] = 0u; grp[10] = 0u; grp[11] = 0u; grp[12] = 0u; grp[13] = 0u; grp[14] = 0u; grp[15] = 0u;
        sort16_desc(grp);
        merge16_desc(fin, grp);
#undef CAND
        float fv[16], sum = 0.f;
        const float fmax0 = key_val<8>(fin[0]);
#pragma unroll
        for (int e = 0; e < 16; ++e) { fv[e] = __expf(key_val<8>(fin[e]) - fmax0); sum += fv[e]; }
        const float inv = 1.f / sum;
        const size_t ob = ((size_t)(t0 + r) * 8 + (hp2 * 2 + hh)) * 16;
#pragma unroll
        for (int q4 = 0; q4 < 4; ++q4) {
            int ev[4]; float gv[4];
#pragma unroll
            for (int q = 0; q < 4; ++q) {
                const int e = q4 * 4 + q;
                const unsigned c = key_payload<8>(fin[e]);
                const unsigned ci = c >> 4, cj = c & 15u;
                const unsigned wa = ibuf[(ci >> 2) * 64 + lane], wb = ibuf[(4 + (cj >> 2)) * 64 + lane];
                const unsigned i1 = (wa >> (8 * (ci & 3u))) & 0xffu, i2 = (wb >> (8 * (cj & 3u))) & 0xffu;
                ev[q] = (int)(i1 * 128u + i2);
                gv[q] = fv[e] * inv;
            }
            *(int4*)(EIDX + ob + q4 * 4) = make_int4(ev[0], ev[1], ev[2], ev[3]);
            *(f32x4*)(GW + ob + q4 * 4) = (f32x4){gv[0], gv[1], gv[2], gv[3]};
        }
    }
}

template <bool SIGNED> __device__ __forceinline__ void cvt_table_i8(const float* __restrict__ src, unsigned char* __restrict__ dst, float* __restrict__ scales, int nrows, const int g_wave) {
    const int lane = lane_id(), wid = g_wave;
    for (int row = blockIdx.x * 8 + wid; row < nrows; row += gridDim.x * 8) {
        const float* sp = src + (size_t)row * 1024 + lane * 16;
        f32x4 v[4];
        float mx = 0.f;
#pragma unroll
        for (int c = 0; c < 4; ++c) { v[c] = *(const f32x4*)(sp + c * 4); mx = fmaxf(mx, fmaxf(fmaxf(fabsf(v[c][0]), fabsf(v[c][1])), fmaxf(fabsf(v[c][2]), fabsf(v[c][3])))); }
#pragma unroll
        for (int o = 32; o > 0; o >>= 1) mx = fmaxf(mx, __shfl_xor(mx, o));
        const float sc = fmaxf(mx, 1e-30f) * (1.f / 127.f), inv = 1.f / sc;
        u32x4 w;
#pragma unroll
        for (int c = 0; c < 4; ++c) {
            unsigned pk = 0;
#pragma unroll
            for (int e = 0; e < 4; ++e) pk |= (SIGNED ? ((unsigned)(int)rintf(v[c][e] * inv) & 0xffu) : (unsigned)((int)rintf(v[c][e] * inv) + 128)) << (8 * e);
            w[c] = pk;
        }
        *(u32x4*)(dst + (size_t)row * 1024 + lane * 16) = w;
        if (lane == 0) scales[row] = sc;
    }
}

__device__ __forceinline__ float ub0(unsigned w) { return (float)(w & 0xffu); }
__device__ __forceinline__ float ub1(unsigned w) { return (float)((w >> 8) & 0xffu); }
__device__ __forceinline__ float ub2(unsigned w) { return (float)((w >> 16) & 0xffu); }
__device__ __forceinline__ float ub3(unsigned w) { return (float)(w >> 24); }

struct GTok { float sh, tsum; float acc[16]; };
__device__ __forceinline__ float gv6_dots8(const u32x4 (&u)[16], int j0, const u32x4 hq_lo, const u32x4 hq_hi, float my_su, float my_gv, float my_sh, int lane) {
    float pj[8];
#pragma unroll
    for (int j = 0; j < 8; ++j) {
        int s = 0;
#pragma unroll
        for (int c = 0; c < 4; ++c) s = __builtin_amdgcn_sdot4((int)u[j0 + j][c], (int)(j < 4 ? hq_lo[c] : hq_hi[c]), s, false);
        pj[j] = (float)s;
    }
    float q4[4], q2[2], q1;
#pragma unroll
    for (int m = 0; m < 4; ++m) {
        const auto rr = __builtin_amdgcn_permlane32_swap(__float_as_uint(pj[m]), __float_as_uint(pj[4 + m]), false, false);
        q4[m] = __uint_as_float(rr[0]) + __uint_as_float(rr[1]);
    }
#pragma unroll
    for (int m = 0; m < 2; ++m) {
        const auto rr = __builtin_amdgcn_permlane16_swap(__float_as_uint(q4[m]), __float_as_uint(q4[2 + m]), false, false);
        q2[m] = __uint_as_float(rr[0]) + __uint_as_float(rr[1]);
    }
    {
        const bool up = (lane & 8) != 0;
        const float keep = up ? q2[1] : q2[0], send = up ? q2[0] : q2[1];
        q1 = keep + __uint_as_float((unsigned)__builtin_amdgcn_update_dpp(0, (int)__float_as_uint(send), 0x128, 0xf, 0xf, false));
    }
    q1 += __uint_as_float((unsigned)__builtin_amdgcn_update_dpp(0, (int)__float_as_uint(q1), 0xB1, 0xf, 0xf, false));
    q1 += __uint_as_float((unsigned)__builtin_amdgcn_update_dpp(0, (int)__float_as_uint(q1), 0x4E, 0xf, 0xf, false));
    q1 += __uint_as_float((unsigned)__builtin_amdgcn_update_dpp(0, (int)__float_as_uint(q1), 0x141, 0xf, 0xf, false));
    const float d = my_su * my_sh * q1;
    return 0.5f * d * (1.f + erff(d * 0.70710678118654752f)) * my_gv;
}
__device__ __forceinline__ void gv6_dots_step(const unsigned char* __restrict__ U8, unsigned* lst0, int k, int ids, float sh01, float sh23, int lane) {
    u32x4 u[16];
#pragma unroll
    for (int j = 0; j < 16; ++j) {
        const int e = __builtin_amdgcn_readlane(ids, j);
        u[j] = *(const u32x4*)(U8 + (size_t)e * 1024 + lane * 16);
    }
    const int tl = lane >> 5, rk = 4 * k + ((lane >> 3) & 3);
    unsigned* la = lst0 + tl * 768; unsigned* lb = lst0 + (2 + tl) * 768;
    const float su_a = __uint_as_float(la[128 + rk]), gv_a = __uint_as_float(la[256 + rk]);
    const float su_b = __uint_as_float(lb[128 + rk]), gv_b = __uint_as_float(lb[256 + rk]);
    const u32x4 h0 = *(const u32x4*)(lst0 + 384 + lane * 4), h1 = *(const u32x4*)(lst0 + 768 + 384 + lane * 4);
    const u32x4 h2 = *(const u32x4*)(lst0 + 1536 + 384 + lane * 4), h3 = *(const u32x4*)(lst0 + 2304 + 384 + lane * 4);
    const float a_a = gv6_dots8(u, 0, h0, h1, su_a, gv_a, sh01, lane);
    const float a_b = gv6_dots8(u, 8, h2, h3, su_b, gv_b, sh23, lane);
    if ((lane & 7) == 0) { la[640 + rk] = __float_as_uint(a_a); lb[640 + rk] = __float_as_uint(a_b); }
}
__device__ __forceinline__ void gv6_accum_step(const unsigned char* __restrict__ V8, int ids, float av, GTok& T0, GTok& T1, GTok& T2, GTok& T3, int lane) {
    u32x4 v[16];
#pragma unroll
    for (int j = 0; j < 16; ++j) {
        const int e = __builtin_amdgcn_readlane(ids, j);
        v[j] = *(const u32x4*)(V8 + (size_t)e * 1024 + lane * 16);
    }
#define GV6_ACC(TK, j) do { const float aj = __builtin_bit_cast(float, __builtin_amdgcn_readlane(__builtin_bit_cast(int, av), (j))); (TK).tsum += aj; \
        _Pragma("unroll") for (int c = 0; c < 4; ++c) { const unsigned w = v[(j)][c]; \
            (TK).acc[4 * c] += aj * ub0(w); (TK).acc[4 * c + 1] += aj * ub1(w); (TK).acc[4 * c + 2] += aj * ub2(w); (TK).acc[4 * c + 3] += aj * ub3(w); } } while (0)
    GV6_ACC(T0, 0); GV6_ACC(T0, 1); GV6_ACC(T0, 2); GV6_ACC(T0, 3);
    GV6_ACC(T1, 4); GV6_ACC(T1, 5); GV6_ACC(T1, 6); GV6_ACC(T1, 7);
    GV6_ACC(T2, 8); GV6_ACC(T2, 9); GV6_ACC(T2, 10); GV6_ACC(T2, 11);
    GV6_ACC(T3, 12); GV6_ACC(T3, 13); GV6_ACC(T3, 14); GV6_ACC(T3, 15);
#undef GV6_ACC
}
__device__ __forceinline__ void gv3_sort128(unsigned& a, unsigned& b, int lane) {
#pragma unroll
    for (int k = 2; k <= 64; k <<= 1) {
        const bool asc_a = (k == 64) ? true : ((lane & k) == 0), asc_b = (k == 64) ? false : ((lane & k) == 0);
#pragma unroll
        for (int j = k >> 1; j >= 1; j >>= 1) {
            const unsigned pa = (unsigned)__shfl_xor((int)a, j), pb = (unsigned)__shfl_xor((int)b, j);
            const bool lower = (lane & j) == 0;
            a = (lower == asc_a) ? (a < pa ? a : pa) : (a > pa ? a : pa);
            b = (lower == asc_b) ? (b < pb ? b : pb) : (b > pb ? b : pb);
        }
    }
    { const unsigned lo = a < b ? a : b, hi = a < b ? b : a; a = lo; b = hi; }
#pragma unroll
    for (int j = 32; j >= 1; j >>= 1) {
        const unsigned pa = (unsigned)__shfl_xor((int)a, j), pb = (unsigned)__shfl_xor((int)b, j);
        const bool lower = (lane & j) == 0;
        a = lower ? (a < pa ? a : pa) : (a > pa ? a : pa);
        b = lower ? (b < pb ? b : pb) : (b > pb ? b : pb);
    }
}
__device__ __forceinline__ void gv3_load_token(GTok& T, unsigned* lst, int tok, const bf16_t* __restrict__ Hb, const int* __restrict__ EIDX, const float* __restrict__ GW,
                                               const float* __restrict__ SU, const float* __restrict__ SV, int lane) {
    float h[16];
    {
        const u32x4 a = *(const u32x4*)(Hb + (size_t)tok * 1024 + lane * 16), b = *(const u32x4*)(Hb + (size_t)tok * 1024 + lane * 16 + 8);
#pragma unroll
        for (int c = 0; c < 4; ++c) { h[2 * c] = bflo(a[c]); h[2 * c + 1] = bfhi(a[c]); h[8 + 2 * c] = bflo(b[c]); h[8 + 2 * c + 1] = bfhi(b[c]); }
    }
    float mx = 0.f;
#pragma unroll
    for (int i = 0; i < 16; ++i) mx = fmaxf(mx, fabsf(h[i]));
#pragma unroll
    for (int o = 32; o > 0; o >>= 1) mx = fmaxf(mx, __shfl_xor(mx, o));
    T.sh = fmaxf(mx, 1e-30f) * (1.f / 127.f);
    const float inv = 1.f / T.sh;
    u32x4 hq;
#pragma unroll
    for (int c = 0; c < 4; ++c) {
        unsigned pk = 0;
#pragma unroll
        for (int e = 0; e < 4; ++e) pk |= ((unsigned)(int)rintf(h[4 * c + e] * inv) & 0xffu) << (8 * e);
        hq[c] = pk;
    }
    *(u32x4*)(lst + 384 + lane * 4) = hq;
    {
        unsigned ka = ((unsigned)EIDX[(size_t)tok * 128 + lane] << 7) | (unsigned)lane, kb = ((unsigned)EIDX[(size_t)tok * 128 + 64 + lane] << 7) | (unsigned)(64 + lane);
        gv3_sort128(ka, kb, lane);
        const int e_lo = (int)(ka >> 7), e_hi = (int)(kb >> 7);
        const float* gwt = GW + (size_t)tok * 128;
        lst[lane] = (unsigned)e_lo; lst[64 + lane] = (unsigned)e_hi;
        lst[128 + lane] = __float_as_uint(SU[e_lo]); lst[192 + lane] = __float_as_uint(SU[e_hi]);
        lst[256 + lane] = __float_as_uint(gwt[ka & 127u] * SV[e_lo]); lst[320 + lane] = __float_as_uint(gwt[kb & 127u] * SV[e_hi]);
    }
    T.tsum = 0.f;
#pragma unroll
    for (int i = 0; i < 16; ++i) T.acc[i] = 0.f;
}
__device__ __forceinline__ void gv3_store_token(const float (&acc)[16], int tok, const bf16_t* X, bf16_t* Xo, const float* __restrict__ gate, const float* __restrict__ ng,
                                                const float* __restrict__ nmod, bf16_t* Hn, float* fout) {
    const int lane = lane_id();
    const bf16_t* xp = X + (size_t)tok * 1024 + lane * 16;
    const float* gp = gate + (size_t)(tok >> 12) * 6144 + lane * 16;
    f32x4 xn[4];
    float ss = 0.f;
    {
        const u32x4 xa = *(const u32x4*)xp, xb = *(const u32x4*)(xp + 8);
        const unsigned xw[8] = {xa.x, xa.y, xa.z, xa.w, xb.x, xb.y, xb.z, xb.w};
#pragma unroll
        for (int c = 0; c < 4; ++c) {
            const f32x4 gv = *(const f32x4*)(gp + c * 4);
            const float xv[4] = {bflo(xw[2 * c]), bfhi(xw[2 * c]), bflo(xw[2 * c + 1]), bfhi(xw[2 * c + 1])};
#pragma unroll
            for (int e = 0; e < 4; ++e) { xn[c][e] = xv[e] + gv[e] * acc[4 * c + e]; ss += xn[c][e] * xn[c][e]; }
        }
    }
    if (ng == nullptr || fout == nullptr) {
        bf16_t* xo = Xo + (size_t)tok * 1024 + lane * 16;
        *(u32x4*)xo = (u32x4){cvt_pk_bf16(xn[0][0], xn[0][1]), cvt_pk_bf16(xn[0][2], xn[0][3]), cvt_pk_bf16(xn[1][0], xn[1][1]), cvt_pk_bf16(xn[1][2], xn[1][3])};
        *(u32x4*)(xo + 8) = (u32x4){cvt_pk_bf16(xn[2][0], xn[2][1]), cvt_pk_bf16(xn[2][2], xn[2][3]), cvt_pk_bf16(xn[3][0], xn[3][1]), cvt_pk_bf16(xn[3][2], xn[3][3])};
    }
    if (ng != nullptr) {
        ss = warp_sum(ss);
        const float rs = rsqrtf(ss * (1.f / 1024.f) + 1e-6f);
        if (fout != nullptr) {
#pragma unroll
            for (int c = 0; c < 4; ++c) {
                const f32x4 gg = *(const f32x4*)(ng + lane * 16 + c * 4);
                *(f32x4*)(fout + (size_t)tok * 1024 + lane * 16 + c * 4) = xn[c] * rs * gg;
            }
        } else {
            const float* shp = nmod + (size_t)(tok >> 12) * 6144 + lane * 16;
            unsigned w[8];
#pragma unroll
            for (int c = 0; c < 4; ++c) {
                const f32x4 gg = *(const f32x4*)(ng + lane * 16 + c * 4), sh = *(const f32x4*)(shp + c * 4), sc = *(const f32x4*)(shp + 1024 + c * 4);
                float y[4];
#pragma unroll
                for (int e = 0; e < 4; ++e) y[e] = xn[c][e] * rs * gg[e] * (1.f + sc[e]) + sh[e];
                w[2 * c] = cvt_pk_bf16(y[0], y[1]); w[2 * c + 1] = cvt_pk_bf16(y[2], y[3]);
            }
            *(u32x4*)(Hn + (size_t)tok * 1024 + lane * 16) = (u32x4){w[0], w[1], w[2], w[3]};
            *(u32x4*)(Hn + (size_t)tok * 1024 + lane * 16 + 8) = (u32x4){w[4], w[5], w[6], w[7]};
        }
    }
}
__device__ __forceinline__ void ph_gather9(const bf16_t* __restrict__ Hb, const unsigned char* __restrict__ U8, const unsigned char* __restrict__ V8,
                                           const float* __restrict__ SU, const float* __restrict__ SV, const int* __restrict__ EIDX,
                                           const float* __restrict__ GW, const bf16_t* X, bf16_t* Xo, const float* __restrict__ gate,
                                           const float* __restrict__ ng, const float* __restrict__ nmod, bf16_t* Hn, float* fout, unsigned char* smem, const int g_wave) {
    const int lane = lane_id(), wid = g_wave;
    const int wg = blockIdx.x * 8 + wid, NW = gridDim.x * 8;
    f32x4* accl = (f32x4*)(smem + wid * 16384) + lane;
    unsigned* lst0 = (unsigned*)(smem + wid * 16384);
    for (int base = wg * 4; base < NTOK; base += NW * 4) {
        GTok T0, T1, T2, T3;
        gv3_load_token(T0, lst0, base + 0, Hb, EIDX, GW, SU, SV, lane); gv3_load_token(T1, lst0 + 768, base + 1, Hb, EIDX, GW, SU, SV, lane);
        gv3_load_token(T2, lst0 + 1536, base + 2, Hb, EIDX, GW, SU, SV, lane); gv3_load_token(T3, lst0 + 2304, base + 3, Hb, EIDX, GW, SU, SV, lane);
        {
            const unsigned* idp = lst0 + ((lane >> 2) & 3) * 768 + (lane & 3);
            const float sh01 = (lane < 32) ? T0.sh : T1.sh, sh23 = (lane < 32) ? T2.sh : T3.sh;
            int ids = (int)idp[0];
#pragma unroll 1
            for (int k = 0; k < 32; ++k) {
                const int cur = ids;
                ids = (int)idp[(4 * (k + 1)) & 127];
                gv6_dots_step(U8, lst0, k, cur, sh01, sh23, lane);
                if ((k & 15) == 15) __syncthreads();
            }
            ids = (int)idp[0];
            float av = __uint_as_float(idp[640]);
#pragma unroll 1
            for (int k = 0; k < 32; ++k) {
                const int cur = ids; const float cav = av;
                ids = (int)idp[(4 * (k + 1)) & 127]; av = __uint_as_float(idp[640 + ((4 * (k + 1)) & 127)]);
                gv6_accum_step(V8, cur, cav, T0, T1, T2, T3, lane);
                if ((k & 15) == 15) __syncthreads();
            }
        }
        asm volatile("" ::: "memory");
#define GV3_PARK(TK, tk) do { const float t128 = 128.f * (TK).tsum;        \
            _Pragma("unroll") for (int c = 0; c < 4; ++c) accl[((tk) * 4 + c) * 64] = (f32x4){(TK).acc[4 * c] - t128, (TK).acc[4 * c + 1] - t128, (TK).acc[4 * c + 2] - t128, (TK).acc[4 * c + 3] - t128}; } while (0)
        GV3_PARK(T0, 0); GV3_PARK(T1, 1); GV3_PARK(T2, 2); GV3_PARK(T3, 3);
#undef GV3_PARK
#pragma unroll 1
        for (int tk = 0; tk < 4; ++tk) {
            float acc[16];
#pragma unroll
            for (int c = 0; c < 4; ++c) { const f32x4 t4 = accl[(tk * 4 + c) * 64]; acc[4 * c] = t4[0]; acc[4 * c + 1] = t4[1]; acc[4 * c + 2] = t4[2]; acc[4 * c + 3] = t4[3]; }
            gv3_store_token(acc, base + tk, X, Xo, gate, ng, nmod, Hn, fout);
        }
        asm volatile("" ::: "memory");
    }
}

__device__ __forceinline__ void ph_filt_mlp(const MP& p, unsigned char* smem, const int g_wave) {
    const int lane = lane_id(), wid = g_wave, tid = (wid << 6) | lane;
    float* wl = (float*)smem;
    float* buf = (float*)(smem + 49152) + wid * 128;
    const float* w1 = p.in[18]; const float* b1 = p.in[19]; const float* w2 = p.in[20]; const float* b2 = p.in[21];
    const float* w3 = p.in[22]; const float* b3 = p.in[23]; const float* fq = p.in[25];
    float* a3 = (float*)(p.ws + WS_A3);
    __syncthreads();
    for (int e = tid; e < 33 * 64; e += 512) wl[e] = w1[e];
    for (int e = tid; e < 64 * 64; e += 512) { wl[2112 + e] = w2[e]; wl[6208 + e] = w3[e]; }
    __syncthreads();
    const float fr = fq[lane], bb1 = b1[lane], bb2 = b2[lane], bb3 = b3[lane];
    for (int pos = blockIdx.x * 8 + wid; pos < FILT_L; pos += gridDim.x * 8) {
        const float L = (float)FILT_L;
        float zv = 0.f;
        if (lane < 33) {
            const float t = (float)pos / (L - 1.f);
            const float w = (2.0f * 3.14159265358979323846f / L) * (float)pos;
            if (lane == 0) zv = t;
            else {
                const int bnd = (lane - 1) & 15;
                const float f = 1e-4f + (float)bnd * ((15.f - 1e-4f) / 15.f);
                zv = (lane <= 16) ? cosf(f * w) : -sinf(f * w);
            }
        }
        buf[lane] = zv;
        float acc = bb1;
#pragma unroll 3
        for (int k = 0; k < 33; ++k) acc += buf[k] * wl[k * 64 + lane];
        buf[64 + lane] = sinf(fr * acc);
        acc = bb2;
#pragma unroll 8
        for (int k = 0; k < 64; ++k) acc += buf[64 + k] * wl[2112 + k * 64 + lane];
        buf[lane] = sinf(fr * acc);
        acc = bb3;
#pragma unroll 8
        for (int k = 0; k < 64; ++k) acc += buf[k] * wl[6208 + k * 64 + lane];
        a3[(size_t)pos * 64 + lane] = sinf(fr * acc);
    }
}

__device__ __forceinline__ void ph_filt_table(const MP& p, unsigned char* smem, const int g_wave) {
    const int lane = lane_id(), wid = g_wave, tid = (wid << 6) | lane;
    float* a3s = (float*)smem;
    float* w4s = (float*)(smem + 64 * 65 * 4);
    const float* a3 = (const float*)(p.ws + WS_A3);
    const float* w4 = p.in[24]; const float* deltas = p.in[26];
    bf16_t* FILT = (bf16_t*)(p.ws + WS_FILT);
    float* FNORM = (float*)(p.ws + WS_FNORM);
    for (int u = blockIdx.x; u < 64 * 64; u += gridDim.x) {
        const int pos0 = (u & 63) * 64, col0 = (u >> 6) * 64;
        __syncthreads();
#pragma unroll
        for (int i = 0; i < 8; ++i) {
            const int rr = (tid >> 6) + 8 * i, cc = tid & 63;
            a3s[rr * 65 + cc] = a3[(size_t)(pos0 + rr) * 64 + cc];
            w4s[rr * 64 + cc] = w4[(size_t)rr * 4096 + col0 + cc];
        }
        __syncthreads();
        float acc[8];
#pragma unroll
        for (int cc = 0; cc < 8; ++cc) acc[cc] = 0.f;
#pragma unroll 2
        for (int k = 0; k < 64; ++k) {
            const float av = a3s[lane * 65 + k];
            const f32x4 wa = *(const f32x4*)(w4s + k * 64 + wid * 8), wb = *(const f32x4*)(w4s + k * 64 + wid * 8 + 4);
#pragma unroll
            for (int e = 0; e < 4; ++e) { acc[e] += av * wa[e]; acc[4 + e] += av * wb[e]; }
        }
        const int pos = pos0 + lane;
        const float t = (float)pos / 4095.f;
#pragma unroll
        for (int cc = 0; cc < 8; ++cc) {
            const int col = col0 + wid * 8 + cc;
            const int n = col >> 11, dir = (col >> 10) & 1, c = col & 1023;
            const float v = acc[cc] * __expf(-t * fabsf(deltas[n * 1024 + c]));
            const bool use = (dir == 0) || (pos > 0);
            if (use) FILT[((size_t)(n * 1024 + c)) * 8192 + (dir == 0 ? 4096 - pos : 4096 + pos)] = f2bf(v);
            const float s = warp_sum(use ? fabsf(v) : 0.f);
            if (lane == 0) atomicAdd(FNORM + n * 1024 + c, s);
        }
    }
}

constexpr int CV_RS = 5064, CV_PADL = 480;
constexpr int CV_UBYTES = 8 * CV_RS * 2;
constexpr int CV_FE = CV_UBYTES, CV_FO = CV_FE + 16384 + 64;
__device__ __forceinline__ float sconv_at(const bf16_t* __restrict__ row, int t, float w0, float w1, float w2, float cbv) {
    float a = cbv + w1 * bf2f(row[t]);
    if (t > 0) a += w0 * bf2f(row[t - 1]);
    if (t < SEQ - 1) a += w2 * bf2f(row[t + 1]);
    return a;
}
__device__ __forceinline__ void sconv4(const bf16_t* __restrict__ row, int t, float w0, float w1, float w2, float cbv, float (&o)[4]) {
    const u32x2 w = *(const u32x2*)(row + t);
    const float x0 = bflo(w.x), x1 = bfhi(w.x), x2 = bflo(w.y), x3 = bfhi(w.y);
    const float xm = (t > 0) ? bf2f(row[t - 1]) : 0.f, xp = (t + 4 < SEQ) ? bf2f(row[t + 4]) : 0.f;
    o[0] = cbv + w0 * xm + w1 * x0 + w2 * x1;
    o[1] = cbv + w0 * x0 + w1 * x1 + w2 * x2;
    o[2] = cbv + w0 * x1 + w1 * x2 + w2 * x3;
    o[3] = cbv + w0 * x2 + w1 * x3 + w2 * xp;
}
__device__ __forceinline__ void conv_load_filter(const bf16_t* __restrict__ F, unsigned char* smem, int tid) {
    const u32x4* src = (const u32x4*)F;
#pragma unroll
    for (int i = 0; i < 2; ++i) *(u32x4*)(smem + CV_FE + (tid + 512 * i) * 16) = src[tid + 512 * i];
    const unsigned* sd = (const unsigned*)F;
#pragma unroll
    for (int i = 0; i < 8; ++i) {
        const int y = tid + 512 * i;
        const unsigned lo = sd[y], hi = (y < 4095) ? sd[y + 1] : 0u;
        *(unsigned*)(smem + CV_FO + y * 4) = (lo >> 16) | (hi << 16);
    }
}
__device__ __forceinline__ u32x4 cv_taps(const unsigned char* fp) { u32x4 a; a.x = *(const unsigned*)(fp); a.y = *(const unsigned*)(fp + 4); a.z = *(const unsigned*)(fp + 8); a.w = *(const unsigned*)(fp + 12); return a; }
template <int MODE>
__device__ __forceinline__ void conv_block(const unsigned char* fp, const unsigned char* up, bf16x8 (&R)[26], u32x4& A0, u32x4& A1, f32x16 (&acc)[4]) {
#pragma unroll
    for (int j = 0; j < 26; ++j) {
        if (MODE != 2 || j < 25) {
            R[(j + 1) % 26] = *(const bf16x8*)(up - 32 * (j + 1));
            if (j & 1) A0 = cv_taps(fp - 32 * (j + 1)); else A1 = cv_taps(fp - 32 * (j + 1));
        }
        const bf16x8 af = __builtin_bit_cast(bf16x8, (j & 1) ? A1 : A0);
        if (MODE != 2 || j <= 1) acc[0] = __builtin_amdgcn_mfma_f32_32x32x16_bf16(af, R[j], acc[0], 0, 0, 0);
        if ((MODE != 0 || j >= 8) && (MODE != 2 || j <= 9)) acc[1] = __builtin_amdgcn_mfma_f32_32x32x16_bf16(af, R[(j + 18) % 26], acc[1], 0, 0, 0);
        if ((MODE != 0 || j >= 16) && (MODE != 2 || j <= 17)) acc[2] = __builtin_amdgcn_mfma_f32_32x32x16_bf16(af, R[(j + 10) % 26], acc[2], 0, 0, 0);
        if (MODE != 0 || j >= 24) acc[3] = __builtin_amdgcn_mfma_f32_32x32x16_bf16(af, R[(j + 2) % 26], acc[3], 0, 0, 0);
    }
}
__device__ __forceinline__ void conv_main(const unsigned char* smem, int wid, int lane, f32x16 (&acc)[4]) {
    const int i = lane & 31, hh = lane >> 5, n = lane & 31, b = n >> 2, q = n & 3;
    const int T0w = 512 * wid, d0 = T0w - 4080;
#pragma unroll
    for (int a = 0; a < 4; ++a) acc[a] = (f32x16){};
    const unsigned char* fp = smem + ((i & 1) ? CV_FO : CV_FE) + ((4096 - i + 8 * hh) >> 1) * 4 - d0 * 2;
    const unsigned char* up = smem + (b * CV_RS + CV_PADL + 32 * q + 8 * hh + (T0w - d0)) * 2;
    bf16x8 R[26];
    u32x4 A0, A1;
    R[0] = *(const bf16x8*)up;
    A0 = cv_taps(fp);
    conv_block<0>(fp, up, R, A0, A1, acc);
    fp -= 32 * 26; up -= 32 * 26;
#pragma unroll 1
    for (int outer = 1; outer < 10; ++outer) {
        conv_block<1>(fp, up, R, A0, A1, acc);
        fp -= 32 * 26; up -= 32 * 26;
    }
    conv_block<2>(fp, up, R, A0, A1, acc);
}
__device__ __forceinline__ void ph_conv(const MP& p, const bf16_t* __restrict__ pT, bf16_t* __restrict__ z2T, unsigned char* smem, const int g_wave) {
    const int wid = g_wave;
    const float* cw = p.in[16]; const float* cb = p.in[17]; const float* hbias = p.in[27];
    const bf16_t* FILT = (const bf16_t*)(p.ws + WS_FILT);
    const float* FNORM = (const float*)(p.ws + WS_FNORM);
    for (int c = blockIdx.x; c < 1024; c += gridDim.x) {
        __syncthreads();
        {
            const int tid = (wid << 6) | lane_id();
            const float w0 = cw[c], w1 = cw[3072 + c], w2 = cw[6144 + c], cbv = cb[c];
            for (int ch = tid; ch < 8 * 512; ch += 512) {
                const int b_ = ch >> 9, s8 = (ch & 511) * 8;
                const bf16_t* row = pT + (size_t)c * NTOK + (size_t)b_ * SEQ;
                float o0[4], o1[4];
                sconv4(row, s8, w0, w1, w2, cbv, o0);
                sconv4(row, s8 + 4, w0, w1, w2, cbv, o1);
                u32x4 w; w.x = cvt_pk_bf16(o0[0], o0[1]); w.y = cvt_pk_bf16(o0[2], o0[3]); w.z = cvt_pk_bf16(o1[0], o1[1]); w.w = cvt_pk_bf16(o1[2], o1[3]);
                *(u32x4*)(smem + (b_ * CV_RS + CV_PADL + s8) * 2) = w;
            }
            for (int e = tid; e < 8 * 484; e += 512) {
                const int b_ = e / 484, k = e % 484;
                const int off = (k < 240) ? k * 2 : (CV_PADL + SEQ + (k - 240) * 2);
                *(unsigned*)(smem + (b_ * CV_RS + off) * 2) = 0u;
            }
            conv_load_filter(FILT + (size_t)c * 8192, smem, tid);
        }
        __syncthreads();
        f32x16 acc[4];
        conv_main(smem, wid, lane_id(), acc);
        __syncthreads();
        {
            const int lane = lane_id(), tid = (wid << 6) | lane, hh = lane >> 5, n = lane & 31, b = n >> 2, q = n & 3;
            const int ch1 = 1024 + c;
            const float w0 = cw[ch1], w1 = cw[3072 + ch1], w2 = cw[6144 + ch1], cbv = cb[ch1];
            const float inv = 1.f / FNORM[c], bs = hbias[c];
            const bf16_t* row = pT + (size_t)ch1 * NTOK + (size_t)b * SEQ;
#pragma unroll
            for (int a = 0; a < 4; ++a)
#pragma unroll
                for (int g4 = 0; g4 < 4; ++g4) {
                    const int t = 512 * wid + 128 * a + 32 * q + 8 * g4 + 4 * hh;
                    unsigned char* up = smem + (b * CV_RS + CV_PADL + t) * 2;
                    const u32x2 vw = *(const u32x2*)up;
                    const float vv[4] = {bflo(vw.x), bfhi(vw.x), bflo(vw.y), bfhi(vw.y)};
                    float xs[4], z[4];
                    sconv4(row, t, w0, w1, w2, cbv, xs);
#pragma unroll
                    for (int e = 0; e < 4; ++e) z[e] = xs[e] * (acc[a][4 * g4 + e] * inv + bs * vv[e]);
                    u32x2 zw; zw.x = cvt_pk_bf16(z[0], z[1]); zw.y = cvt_pk_bf16(z[2], z[3]);
                    *(u32x2*)up = zw;
                }
            conv_load_filter(FILT + (size_t)(1024 + c) * 8192, smem, tid);
        }
        __syncthreads();
        conv_main(smem, wid, lane_id(), acc);
        {
            const int lane = lane_id(), hh = lane >> 5, n = lane & 31, b = n >> 2, q = n & 3;
            const int ch2 = 2048 + c;
            const float w0 = cw[ch2], w1 = cw[3072 + ch2], w2 = cw[6144 + ch2], cbv = cb[ch2];
            const float inv = 1.f / FNORM[1024 + c], bs = hbias[1024 + c];
            const bf16_t* row = pT + (size_t)ch2 * NTOK + (size_t)b * SEQ;
            bf16_t* orow = z2T + (size_t)c * NTOK + (size_t)b * SEQ;
#pragma unroll
            for (int a = 0; a < 4; ++a)
#pragma unroll
                for (int g4 = 0; g4 < 4; ++g4) {
                    const int t = 512 * wid + 128 * a + 32 * q + 8 * g4 + 4 * hh;
                    const u32x2 vw = *(const u32x2*)(smem + (b * CV_RS + CV_PADL + t) * 2);
                    const float vv[4] = {bflo(vw.x), bfhi(vw.x), bflo(vw.y), bfhi(vw.y)};
                    float xs[4], z[4];
                    sconv4(row, t, w0, w1, w2, cbv, xs);
#pragma unroll
                    for (int e = 0; e < 4; ++e) z[e] = xs[e] * (acc[a][4 * g4 + e] * inv + bs * vv[e]);
                    u32x2 zw; zw.x = cvt_pk_bf16(z[0], z[1]); zw.y = cvt_pk_bf16(z[2], z[3]);
                    *(u32x2*)(orow + t) = zw;
                }
        }
    }
}

__device__ __forceinline__ void ph_transpose(const bf16_t* __restrict__ src, bf16_t* __restrict__ dst, unsigned char* smem, const int g_wave) {
    const int tid = MYTID;
    bf16_t* tile = (bf16_t*)smem;
    const int rr = tid >> 3, cc = (tid & 7) * 8;
    for (int u = blockIdx.x; u < (1024 / 64) * (NTOK / 64); u += gridDim.x) {
        const int c0 = (u & 15) * 64, t0 = (u >> 4) * 64;
        const u32x4 w = *(const u32x4*)(src + (size_t)(c0 + rr) * NTOK + t0 + cc);
        __syncthreads();
#pragma unroll
        for (int e = 0; e < 4; ++e) *(unsigned*)(tile + rr * 66 + cc + 2 * e) = w[e];
        __syncthreads();
        unsigned short v[8];
#pragma unroll
        for (int e = 0; e < 8; ++e) v[e] = tile[(cc + e) * 66 + rr];
        u32x4 o;
        o.x = (unsigned)v[0] | ((unsigned)v[1] << 16); o.y = (unsigned)v[2] | ((unsigned)v[3] << 16);
        o.z = (unsigned)v[4] | ((unsigned)v[5] << 16); o.w = (unsigned)v[6] | ((unsigned)v[7] << 16);
        *(u32x4*)(dst + (size_t)(t0 + rr) * 1024 + c0 + cc) = o;
    }
}

#define XB_TMO      128
#define XB_XCNT(j)  (256  + 64 * (j))
#define XB_XSUB(j)  (1280 + 64 * (j))
#define XB_XGEN(j)  (2304 + 64 * (j))
#define XB_TOP      3328
#define XB_TOPGEN   3392
#define XCD_BAR_WORDS 3456
#define XB_SPIN_CAP (1u << 22)
__device__ __forceinline__ unsigned xb_ld(unsigned* p)              { return __hip_atomic_load(p, __ATOMIC_RELAXED, __HIP_MEMORY_SCOPE_AGENT); }
__device__ __forceinline__ unsigned xb_add(unsigned* p, unsigned v) { return __hip_atomic_fetch_add(p, v, __ATOMIC_RELAXED, __HIP_MEMORY_SCOPE_AGENT); }
__device__ __forceinline__ unsigned xb_xcc_id() { return (unsigned)__builtin_amdgcn_s_getreg((3 << 11) | 20) & 0xFu; }
#define XB_SPIN(cond, bar) do { unsigned _sp = 0; while (cond) { __builtin_amdgcn_s_sleep(1); \
    if ((++_sp & 255u) == 0u) { if (xb_ld(&(bar)[XB_TMO])) break; if (_sp > XB_SPIN_CAP) { atomicAdd(&(bar)[XB_TMO], 1u); break; } } } } while (0)
struct XcdBarrier { unsigned* bar; unsigned x; volatile LAS unsigned* st; };
__device__ __forceinline__ XcdBarrier xcd_barrier_post(unsigned* bar, volatile LAS unsigned* st, int tid) {
    XcdBarrier b; b.bar = bar; b.x = xb_xcc_id(); b.st = st;
    if (tid == 0) (void)xb_add(&bar[XB_XCNT(b.x)], 1u);
    return b;
}
__device__ __forceinline__ void xcd_barrier_complete(unsigned* bar, unsigned x, unsigned& nloc, unsigned& nx) {
    const unsigned G = gridDim.x;
    unsigned sum, cnt, mine, sp = 0u;
    for (;;) {
        sum = 0u; cnt = 0u; mine = 0u;
#pragma unroll
        for (unsigned j = 0; j < 16; ++j) { const unsigned c = xb_ld(&bar[XB_XCNT(j)]); sum += c; cnt += (c > 0u) ? 1u : 0u; mine = (j == x) ? c : mine; }
        if (sum == G) break;
        __builtin_amdgcn_s_sleep(1);
        if ((++sp & 255u) == 0u) { if (xb_ld(&bar[XB_TMO])) break; if (sp > XB_SPIN_CAP) { atomicAdd(&bar[XB_TMO], 1u); break; } }
    }
    nloc = mine > 0u ? mine : 1u; nx = cnt > 0u ? cnt : 1u;
}
__device__ __forceinline__ void xcd_barrier(const XcdBarrier& b, int tid) {
    asm volatile("s_waitcnt vmcnt(0)" ::: "memory");
    __syncthreads();
    if (tid == 0) {
        unsigned* bar = b.bar;
        __builtin_amdgcn_s_waitcnt(0);
        unsigned nloc = b.st[0], nx = b.st[1];
        if (nloc == 0u) { xcd_barrier_complete(bar, b.x, nloc, nx); b.st[0] = nloc; b.st[1] = nx; }
        const unsigned old = xb_add(&bar[XB_XSUB(b.x)], 1u);
        const unsigned gen = old / nloc;
        if (old + 1u == (gen + 1u) * nloc) {
            __builtin_amdgcn_fence(__ATOMIC_RELEASE, "agent");
            asm volatile("s_waitcnt vmcnt(0)" ::: "memory");
            const unsigned og = xb_add(&bar[XB_TOP], 1u);
            const unsigned tg = og / nx;
            if (og + 1u == (tg + 1u) * nx) xb_add(&bar[XB_TOPGEN], 1u);
            else XB_SPIN(xb_ld(&bar[XB_TOPGEN]) == tg, bar);
            __builtin_amdgcn_fence(__ATOMIC_ACQUIRE, "agent");
            xb_add(&bar[XB_XGEN(b.x)], 1u);
            asm volatile("s_waitcnt vmcnt(0)" ::: "memory");
        } else {
            XB_SPIN(xb_ld(&bar[XB_XGEN(b.x)]) == gen, bar);
            __builtin_amdgcn_fence(__ATOMIC_ACQUIRE, "agent");
            asm volatile("s_waitcnt vmcnt(0)" ::: "memory");
        }
    }
    __syncthreads();
}

#define RUN(k) (p.ph_lo <= (k) && (k) < p.ph_hi)
#define SYNC(k) do { if (p.ph_lo <= (k) && (k) + 1 < p.ph_hi) { if ((k) == 0) cg::this_grid().sync(); else xcd_barrier(xb, MYTID); } } while (0)
__global__ void __launch_bounds__(512, 2) mega(MP p) {
    __shared__ __attribute__((aligned(16))) unsigned char smem[STAGE_BYTES + 16];
    const int g_wave = __builtin_amdgcn_readfirstlane((int)(threadIdx.x >> 6));
    unsigned char* ws = p.ws;
    unsigned char* os = (unsigned char*)p.out;
    const int G = gridDim.x, bid = blockIdx.x;
    const float* modv = (const float*)(ws + WS_MODV);
    const float* rope = (const float*)(ws + WS_ROPE);
    float* RQ = (float*)(ws + WS_RQ);
    float* RK = (float*)(ws + WS_RK);
    bf16_t* Hb = (bf16_t*)(ws + WS_T0);
    bf16_t* Qb = (bf16_t*)(ws + WS_T0);
    bf16_t* Kb = (bf16_t*)(ws + WS_KB);
    bf16_t* VT = (bf16_t*)(ws + WS_VT);
    bf16_t* KRb = (bf16_t*)(ws + WS_KR);
    bf16_t* LATb = (bf16_t*)(os + OUT_LAT);
    bf16_t* Ob = (bf16_t*)(os + OUT_OB);
    bf16_t* X = (bf16_t*)(ws + WS_X);
    LAS unsigned char* lds = (LAS unsigned char*)smem;
    volatile LAS unsigned* xst = (volatile LAS unsigned*)(lds + STAGE_BYTES);
    if (MYTID == 0) { xst[0] = 0u; xst[1] = 0u; }
    __syncthreads();
    const XcdBarrier xb = xcd_barrier_post((unsigned*)(ws + WS_CTL), xst, MYTID);
    bf16_t* Hb2 = (bf16_t*)(ws + WS_T0);
    bf16_t* PQ = (bf16_t*)(ws + WS_T0 + 64 * MiB);
    int* EIDX = (int*)(ws + WS_T0 + 192 * MiB);
    float* GW = (float*)(ws + WS_T0 + 208 * MiB);
    const unsigned char* U8 = ws + WS_PT;
    const unsigned char* V8 = U8 + 16 * MiB;
    const float* PSC = (const float*)(ws + WS_PSC);
    const float* modv1 = modv + 9 * 6144;
    bf16_t* pT = (bf16_t*)(ws + WS_T0 + 64 * MiB);
    bf16_t* z2T = (bf16_t*)(ws + WS_T0);
    bf16_t* z2 = (bf16_t*)(ws + WS_T0 + 64 * MiB);
    if (((DUPSET >> 0) & 1) && RUN(0)) { constexpr bool dup = true; (void)dup; ph_prep(p, smem, g_wave); xcd_barrier(xb, MYTID); }
    if (RUN(0)) { constexpr bool dup = false; (void)dup; ph_prep(p, smem, g_wave); }
    SYNC(0);
    if (((DUPSET >> 1) & 1) && RUN(1)) { constexpr bool dup = true; (void)dup; ph_normmod<0>(p.in[0], p.in[2], p.in[6], modv, 0, Hb, g_wave); if (!dup) ph_filt_table(p, smem, g_wave); xcd_barrier(xb, MYTID); }
    if (RUN(1)) { constexpr bool dup = false; (void)dup; ph_normmod<0>(p.in[0], p.in[2], p.in[6], modv, 0, Hb, g_wave); if (!dup) ph_filt_table(p, smem, g_wave); }
    SYNC(1);
    if (((DUPSET >> 2) & 1) && RUN(2)) { constexpr bool dup = true; (void)dup; {
            Gemm g{Hb, (const bf16_t*)(ws + WS_WDKV), 1024, 1024, 1024};
            TileOrder S; S.init(NROW / 256, 3, G, bid, 0);
            EpiStoreBf16 E{LATb, 768};
            gemm_phase(lds, g, S, E, g_wave);
        } xcd_barrier(xb, MYTID); }
    if (RUN(2)) { constexpr bool dup = false; (void)dup; {
            Gemm g{Hb, (const bf16_t*)(ws + WS_WDKV), 1024, 1024, 1024};
            TileOrder S; S.init(NROW / 256, 3, G, bid, 0);
            EpiStoreBf16 E{LATb, 768};
            gemm_phase(lds, g, S, E, g_wave);
        } }
    SYNC(2);
    if (((DUPSET >> 3) & 1) && RUN(3)) { constexpr bool dup = true; (void)dup; ph_latpost(LATb, rope, RQ, RK, KRb, g_wave); xcd_barrier(xb, MYTID); }
    if (RUN(3)) { constexpr bool dup = false; (void)dup; ph_latpost(LATb, rope, RQ, RK, KRb, g_wave); }
    SYNC(3);
    if (((DUPSET >> 4) & 1) && RUN(4)) { constexpr bool dup = true; (void)dup; {
            {
                Gemm g{LATb, (const bf16_t*)(ws + WS_WUQ), QLORA, 768, QLORA};
                TileOrder S; S.init(NTOK / 256, 6, G, bid, 1);
                EpiQ E{Qb, RQ, rope};
                gemm_phase(lds, g, S, E, g_wave);
            }
            {
                Gemm g{LATb + QLORA, (const bf16_t*)(ws + WS_WK), KVLORA, 768, KVLORA};
                TileOrder S; S.init(NROW / 256, 4, G, bid, 0);
                EpiRowScale E{Kb, 1024, RK};
                gemm_phase(lds, g, S, E, g_wave);
            }
            {
                Gemm g{(const bf16_t*)(ws + WS_WV), LATb + QLORA, KVLORA, KVLORA, 768};
                TileOrder S; S.init(4, NROW / 256, G, bid, 0);
                EpiColScale E{VT, NROW, RK};
                gemm_phase(lds, g, S, E, g_wave);
            }
        } xcd_barrier(xb, MYTID); }
    if (RUN(4)) { constexpr bool dup = false; (void)dup; {
            {
                Gemm g{LATb, (const bf16_t*)(ws + WS_WUQ), QLORA, 768, QLORA};
                TileOrder S; S.init(NTOK / 256, 6, G, bid, 1);
                EpiQ E{Qb, RQ, rope};
                gemm_phase(lds, g, S, E, g_wave);
            }
            {
                Gemm g{LATb + QLORA, (const bf16_t*)(ws + WS_WK), KVLORA, 768, KVLORA};
                TileOrder S; S.init(NROW / 256, 4, G, bid, 0);
                EpiRowScale E{Kb, 1024, RK};
                gemm_phase(lds, g, S, E, g_wave);
            }
            {
                Gemm g{(const bf16_t*)(ws + WS_WV), LATb + QLORA, KVLORA, KVLORA, 768};
                TileOrder S; S.init(4, NROW / 256, G, bid, 0);
                EpiColScale E{VT, NROW, RK};
                gemm_phase(lds, g, S, E, g_wave);
            }
        } }
    SYNC(4);
    if (((DUPSET >> 5) & 1) && RUN(5)) { constexpr bool dup = true; (void)dup; ph_attn(Qb, Kb, KRb, VT, Ob, smem, g_wave); xcd_barrier(xb, MYTID); }
    if (RUN(5)) { constexpr bool dup = false; (void)dup; ph_attn(Qb, Kb, KRb, VT, Ob, smem, g_wave); }
    SYNC(5);
    if (((DUPSET >> 6) & 1) && RUN(6)) { constexpr bool dup = true; (void)dup; {
            Gemm g{Ob, (const bf16_t*)(ws + WS_WO), 1024, 1024, 1024};
            TileOrder S; S.init(NTOK / 256, 4, G, bid, 0);
            EpiResid<true> E{X, p.in[0], modv + 2 * 1024};
            gemm_phase(lds, g, S, E, g_wave);
        } xcd_barrier(xb, MYTID); }
    if (RUN(6)) { constexpr bool dup = false; (void)dup; {
            Gemm g{Ob, (const bf16_t*)(ws + WS_WO), 1024, 1024, 1024};
            TileOrder S; S.init(NTOK / 256, 4, G, bid, 0);
            EpiResid<true> E{X, p.in[0], modv + 2 * 1024};
            gemm_phase(lds, g, S, E, g_wave);
        } }
    SYNC(6);
    if (((DUPSET >> 7) & 1) && RUN(7)) { constexpr bool dup = true; (void)dup; ph_normmod<1>((const float*)X, nullptr, p.in[7], modv, 3, Hb2, g_wave); xcd_barrier(xb, MYTID); }
    if (RUN(7)) { constexpr bool dup = false; (void)dup; ph_normmod<1>((const float*)X, nullptr, p.in[7], modv, 3, Hb2, g_wave); }
    SYNC(7);
    if (((DUPSET >> 8) & 1) && RUN(8)) { constexpr bool dup = true; (void)dup; {
            Gemm g{Hb2, (const bf16_t*)(ws + WS_WQ), 1024, 1024, 1024};
            TileOrder S; S.init(NTOK / 256, 8, G, bid, 0);
            EpiStoreBf16 E{PQ, 2048};
            gemm_phase(lds, g, S, E, g_wave);
        } xcd_barrier(xb, MYTID); }
    if (RUN(8)) { constexpr bool dup = false; (void)dup; {
            Gemm g{Hb2, (const bf16_t*)(ws + WS_WQ), 1024, 1024, 1024};
            TileOrder S; S.init(NTOK / 256, 8, G, bid, 0);
            EpiStoreBf16 E{PQ, 2048};
            gemm_phase(lds, g, S, E, g_wave);
        } }
    SYNC(8);
    if (((DUPSET >> 9) & 1) && RUN(9)) { constexpr bool dup = true; (void)dup; ph_route(PQ, (const bf16_t*)(ws + WS_KEYS), EIDX, GW, smem, g_wave); xcd_barrier(xb, MYTID); }
    if (RUN(9)) { constexpr bool dup = false; (void)dup; ph_route(PQ, (const bf16_t*)(ws + WS_KEYS), EIDX, GW, smem, g_wave); }
    SYNC(9);
    if (((DUPSET >> 10) & 1) && RUN(10)) { constexpr bool dup = true; (void)dup; ph_gather9(Hb2, U8, V8, PSC, PSC + 16384, EIDX, GW, X, dup ? (bf16_t*)PQ : X, modv + 5 * 1024, dup ? nullptr : p.in[6] + 1024, modv1, Hb2, nullptr, smem, g_wave); xcd_barrier(xb, MYTID); }
    if (RUN(10)) { constexpr bool dup = false; (void)dup; ph_gather9(Hb2, U8, V8, PSC, PSC + 16384, EIDX, GW, X, dup ? (bf16_t*)PQ : X, modv + 5 * 1024, dup ? nullptr : p.in[6] + 1024, modv1, Hb2, nullptr, smem, g_wave); }
    SYNC(10);
    if (((DUPSET >> 12) & 1) && RUN(12)) { constexpr bool dup = true; (void)dup; {
            Gemm g{(const bf16_t*)(ws + WS_WIN), Hb2, 1024, 1024, 1024};
            TileOrder S; S.init(12, NTOK / 256, G, bid, 0);
            EpiStoreBf16 E{pT, NTOK};
            gemm_phase(lds, g, S, E, g_wave);
        } xcd_barrier(xb, MYTID); }
    if (RUN(12)) { constexpr bool dup = false; (void)dup; {
            Gemm g{(const bf16_t*)(ws + WS_WIN), Hb2, 1024, 1024, 1024};
            TileOrder S; S.init(12, NTOK / 256, G, bid, 0);
            EpiStoreBf16 E{pT, NTOK};
            gemm_phase(lds, g, S, E, g_wave);
        } }
    SYNC(12);
    if (((DUPSET >> 13) & 1) && RUN(13)) { constexpr bool dup = true; (void)dup; ph_conv(p, pT, z2T, smem, g_wave); xcd_barrier(xb, MYTID); }
    if (RUN(13)) { constexpr bool dup = false; (void)dup; ph_conv(p, pT, z2T, smem, g_wave); }
    SYNC(13);
    if (((DUPSET >> 14) & 1) && RUN(14)) { constexpr bool dup = true; (void)dup; ph_transpose(z2T, z2, smem, g_wave); xcd_barrier(xb, MYTID); }
    if (RUN(14)) { constexpr bool dup = false; (void)dup; ph_transpose(z2T, z2, smem, g_wave); }
    SYNC(14);
    if (((DUPSET >> 15) & 1) && RUN(15)) { constexpr bool dup = true; (void)dup; {
            Gemm g{z2, (const bf16_t*)(ws + WS_WOUT), 1024, 1024, 1024};
            TileOrder S; S.init(NTOK / 256, 4, G, bid, 0);
            EpiResid<false> E{dup ? (bf16_t*)(ws + WS_T0 + 128 * MiB) : X, X, modv1 + 2 * 1024};
            gemm_phase(lds, g, S, E, g_wave);
        } xcd_barrier(xb, MYTID); }
    if (RUN(15)) { constexpr bool dup = false; (void)dup; {
            Gemm g{z2, (const bf16_t*)(ws + WS_WOUT), 1024, 1024, 1024};
            TileOrder S; S.init(NTOK / 256, 4, G, bid, 0);
            EpiResid<false> E{dup ? (bf16_t*)(ws + WS_T0 + 128 * MiB) : X, X, modv1 + 2 * 1024};
            gemm_phase(lds, g, S, E, g_wave);
        } }
    SYNC(15);
    if (((DUPSET >> 16) & 1) && RUN(16)) { constexpr bool dup = true; (void)dup; ph_normmod<1>((const float*)X, nullptr, p.in[7] + 1024, modv1, 3, Hb2, g_wave); xcd_barrier(xb, MYTID); }
    if (RUN(16)) { constexpr bool dup = false; (void)dup; ph_normmod<1>((const float*)X, nullptr, p.in[7] + 1024, modv1, 3, Hb2, g_wave); }
    SYNC(16);
    if (((DUPSET >> 17) & 1) && RUN(17)) { constexpr bool dup = true; (void)dup; {
            Gemm g{Hb2, (const bf16_t*)(ws + WS_WQ) + (size_t)2048 * 1024, 1024, 1024, 1024};
            TileOrder S; S.init(NTOK / 256, 8, G, bid, 0);
            EpiStoreBf16 E{PQ, 2048};
            gemm_phase(lds, g, S, E, g_wave);
        } xcd_barrier(xb, MYTID); }
    if (RUN(17)) { constexpr bool dup = false; (void)dup; {
            Gemm g{Hb2, (const bf16_t*)(ws + WS_WQ) + (size_t)2048 * 1024, 1024, 1024, 1024};
            TileOrder S; S.init(NTOK / 256, 8, G, bid, 0);
            EpiStoreBf16 E{PQ, 2048};
            gemm_phase(lds, g, S, E, g_wave);
        } }
    SYNC(17);
    if (((DUPSET >> 18) & 1) && RUN(18)) { constexpr bool dup = true; (void)dup; ph_route(PQ, (const bf16_t*)(ws + WS_KEYS) + (size_t)16 * 128 * 128, EIDX, GW, smem, g_wave); xcd_barrier(xb, MYTID); }
    if (RUN(18)) { constexpr bool dup = false; (void)dup; ph_route(PQ, (const bf16_t*)(ws + WS_KEYS) + (size_t)16 * 128 * 128, EIDX, GW, smem, g_wave); }
    SYNC(18);
    if (((DUPSET >> 19) & 1) && RUN(19)) { constexpr bool dup = true; (void)dup; ph_gather9(Hb2, U8 + 32 * MiB, V8 + 32 * MiB, PSC + 32768, PSC + 32768 + 16384, EIDX, GW, X, dup ? (bf16_t*)PQ : X, modv1 + 5 * 1024, dup ? nullptr : p.in[8], nullptr, nullptr, dup ? nullptr : p.out, smem, g_wave); xcd_barrier(xb, MYTID); }
    if (RUN(19)) { constexpr bool dup = false; (void)dup; ph_gather9(Hb2, U8 + 32 * MiB, V8 + 32 * MiB, PSC + 32768, PSC + 32768 + 16384, EIDX, GW, X, dup ? (bf16_t*)PQ : X, modv1 + 5 * 1024, dup ? nullptr : p.in[8], nullptr, nullptr, dup ? nullptr : p.out, smem, g_wave); }
}

static inline size_t align_up(size_t v, size_t a) { return (v + a - 1) / a * a; }

extern "C" void kernel_launch(void* const* d_in, const int* in_sizes, int n_in, void* d_out, int out_size, void* d_ws,
                              size_t ws_size, hipStream_t stream) {
    float* out = (float*)d_out;

    static int grid_blocks = 0;
    if (!grid_blocks) {
        int dev = 0, cus = 0, per_cu = 0;
        (void)hipGetDevice(&dev);
        (void)hipDeviceGetAttribute(&cus, hipDeviceAttributeMultiprocessorCount, dev);
        (void)hipOccupancyMaxActiveBlocksPerMultiprocessor(&per_cu, mega, 512, 0);
        if (per_cu > 1) per_cu = 1;
        grid_blocks = cus * per_cu;
        if (grid_blocks != 256) { fprintf(stderr, "mega: built for a 256-workgroup grid, got %d\n", grid_blocks); grid_blocks = -1; }
        if (grid_blocks <= 0) { fprintf(stderr, "mega: occupancy query gave %d blocks/CU on %d CUs\n", per_cu, cus); grid_blocks = -1; }
    }
    if (grid_blocks < 0) return;
    MP p{};
    for (int i = 0; i < 33; ++i) p.in[i] = (const float*)d_in[i];
    p.out = out; p.ws = (unsigned char*)d_ws; p.ph_lo = 0; p.ph_hi = OPT_PHASES;
    (void)hipMemsetAsync((char*)d_ws + WS_CTL, 0, 16 * 1024, stream);
    {
        void* args[] = {&p};
        hipError_t e = hipLaunchCooperativeKernel((void*)mega, dim3(grid_blocks), dim3(512), args, 0, stream);
        if (e != hipSuccess) fprintf(stderr, "cooperative launch failed: %s (grid %d)\n", hipGetErrorString(e), grid_blocks);
    }

}
```

```cpp
#include <hip/hip_runtime.h>
#include <hip/hip_cooperative_groups.h>
#include <stdint.h>
#include <math.h>
#include <cstdio>

#ifndef DUPSET
#define DUPSET 0u
#endif
#define OPT_PHASES 21

#define D_MODEL 1024
#define BATCH 8
#define SEQ 4096
#define CTXL 256
#define NH 16
#define QLORA 384
#define KVLORA 256
#define DLAT 672
#define PEER_NK 128
#define FILT_L 4096

__device__ __forceinline__ float warp_sum(float v) {
#pragma unroll
    for (int o = 32; o > 0; o >>= 1) v += __shfl_xor(v, o);
    return v;
}

namespace cg = cooperative_groups;
#define LAS __attribute__((address_space(3)))
#define PG8_LAS LAS
typedef unsigned short bf16_t;
typedef short bf16x8 __attribute__((ext_vector_type(8)));
typedef float f32x4 __attribute__((ext_vector_type(4)));
typedef float f32x16 __attribute__((ext_vector_type(16)));
typedef unsigned u32x4 __attribute__((ext_vector_type(4)));
typedef unsigned u32x2 __attribute__((ext_vector_type(2)));


__device__ __forceinline__ int lane_id() { int l; asm volatile("v_mbcnt_lo_u32_b32 %0, -1, 0\n\tv_mbcnt_hi_u32_b32 %0, -1, %0" : "=v"(l)); return l; }
#define MYTID ((g_wave << 6) | lane_id())
__device__ __forceinline__ unsigned cvt_pk_bf16(float lo, float hi) { unsigned r; asm("v_cvt_pk_bf16_f32 %0, %1, %2" : "=v"(r) : "v"(lo), "v"(hi)); return r; }
__device__ __forceinline__ float bf2f(unsigned b) { return __uint_as_float(b << 16); }
__device__ __forceinline__ float bflo(unsigned w) { return __uint_as_float(w << 16); }
__device__ __forceinline__ float bfhi(unsigned w) { return __uint_as_float(w & 0xffff0000u); }
__device__ __forceinline__ bf16_t f2bf(float f) { return (bf16_t)(cvt_pk_bf16(f, f) & 0xffffu); }

constexpr int NTOK = BATCH * SEQ;
constexpr int NROW = BATCH * (SEQ + CTXL);
constexpr int RPB = SEQ + CTXL;

constexpr size_t KiB = 1024, MiB = 1024 * 1024;
constexpr size_t WS_CTL = 0;
constexpr size_t WS_MODV = 64 * KiB;
constexpr size_t WS_ROPE = 512 * KiB;
constexpr size_t WS_RQ = 1 * MiB;
constexpr size_t WS_RK = 1 * MiB + 160 * KiB;
constexpr size_t WS_FNORM = 1 * MiB + 320 * KiB;
constexpr size_t WS_A3 = 2 * MiB;
constexpr size_t WS_PSC = 3 * MiB;
constexpr size_t WS_WDKV = 4 * MiB;
constexpr size_t WS_WUQ = 5 * MiB + 512 * KiB;
constexpr size_t WS_WK = 7 * MiB;
constexpr size_t WS_WV = 7 * MiB + 512 * KiB;
constexpr size_t WS_WO = 8 * MiB;
constexpr size_t WS_WOUT = 10 * MiB;
constexpr size_t WS_WIN = 12 * MiB;
constexpr size_t WS_WQ = 18 * MiB;
constexpr size_t WS_KEYS = 26 * MiB;
constexpr size_t WS_FILT = 28 * MiB;
constexpr size_t WS_X = 60 * MiB;
constexpr size_t WS_PT = 188 * MiB;
constexpr size_t WS_T0 = 252 * MiB;
constexpr size_t WS_KB = 348 * MiB;
constexpr size_t WS_VT = 416 * MiB;
constexpr size_t WS_KR = 484 * MiB;
constexpr size_t WS_END = 487 * MiB;
constexpr size_t WS_WIN8 = 508 * MiB;
constexpr size_t WS_WIN8S = 511 * MiB;
constexpr size_t OUT_OB = 0;
constexpr size_t OUT_LAT = 64 * MiB;

struct MP {
    const float* in[33];
    float* out;
    unsigned char* ws;
    int ph_lo, ph_hi;
};

constexpr int BM = 256, BK = 64, HALF = 128, HTB = HALF * BK * 2, STAGE_BYTES = 8 * HTB, NXCD = 8, WGM = 1;
__host__ __device__ __forceinline__ int lds_byte(int r, int c) { const int st = (r >> 4) * 2 + (c >> 5), rr = r & 15, cc = c & 31, ob = rr * 64 + cc * 2; return st * 1024 + (ob ^ (((ob >> 9) & 1) << 5)); }
__host__ __device__ __forceinline__ void stage_rc(int b, int& R, int& C) { const int st = b / 1024, sb = b % 1024, swz = sb ^ (((sb >> 9) & 1) << 5); R = (st >> 1) * 16 + swz / 64; C = (st & 1) * 32 + (swz % 64) / 2; }
__host__ __device__ __forceinline__ int perm32(int rho) { const int n = rho >> 4, i = rho & 15; return 8 * (i >> 2) + 4 * n + (i & 3); }
struct Unit { int pm, pn; };
struct Gemm { const bf16_t* A; const bf16_t* Bt; int K, lda, ldb; };
struct TileOrder {
    int nM, nN, nwg, G, c, lat_only;
    __device__ void init(int nM_, int nN_, int G_, int c_, int lat_only_) { nM = nM_; nN = nN_; nwg = nM * nN; G = G_; c = c_; lat_only = lat_only_; }
    __device__ bool next(int i, Unit& u) const {
        const long L = (long)i * G + c; if (L >= nwg) return false;
        int wgid = (int)L; { const int q = nwg / NXCD, r = nwg % NXCD, xcd = wgid % NXCD, off = wgid / NXCD; wgid = (xcd < r ? xcd * (q + 1) : r * (q + 1) + (xcd - r) * q) + off; }
        const int nig = WGM * nN, gid = wgid / nig, fm = gid * WGM, gsz = (nM - fm) < WGM ? (nM - fm) : WGM;
        u.pm = fm + ((wgid % nig) % gsz); u.pn = (wgid % nig) / gsz;
        if (lat_only) u.pm += u.pm >> 4;
        return true;
    }
    __device__ __forceinline__ void a_ready(const Unit&) const {}
    __device__ __forceinline__ void done(const Unit&) const {}
};

typedef int i32x4_t __attribute__((ext_vector_type(4)));
typedef int i32x8_t __attribute__((ext_vector_type(8)));
struct Frag2 { i32x8_t v; };
__device__ __forceinline__ i32x8_t cat16(bf16x8 lo, bf16x8 hi) { const i32x4_t a = __builtin_bit_cast(i32x4_t, lo), b = __builtin_bit_cast(i32x4_t, hi); return __builtin_shufflevector(a, b, 0, 1, 2, 3, 4, 5, 6, 7); }
template <class Epi, class Sched, bool FP8 = false>
__device__ __forceinline__ void gemm_phase(PG8_LAS unsigned char* lds, const Gemm g, const Sched& S, const Epi& E, const int g_wave) {
    int tid_ = MYTID; asm volatile("" : "+v"(tid_));
    const int tid = tid_, wid = __builtin_amdgcn_readfirstlane(tid >> 6), lane = tid & 63, wr = wid >> 2, wc = wid & 3, fr = lane & 15, fq = lane >> 4;
    const int K = g.K, nt = K / BK, lda = g.lda, ldb = g.ldb;
    unsigned voffA, voffB;
    { int R, C; stage_rc(tid * 16, R, C); const int Rb = Epi::PERM ? ((R & ~31) + perm32(R & 31)) : R;
        voffA = (unsigned)(R * lda + C) * 2u; voffB = (unsigned)(Rb * ldb + C) * 2u; }
    const size_t voffA_step = (size_t)64 * lda * 2, voffB_step = (size_t)64 * ldb * 2;
    const size_t kstep = (size_t)(BK * 2);
    const size_t hstepA = (size_t)HALF * lda * 2, hstepB = (size_t)HALF * ldb * 2;
    const size_t tstepA = 2 * hstepA, tstepB = 2 * hstepB;
    const unsigned ldsw = (unsigned)wid * 1024u;
    const int aoff = lds_byte(wr * 64 + fr, fq * 8), boff = lds_byte(wc * 32 + fr, fq * 8);
#define PG8_SA(b, h) (((b) * 2 + (h)) * HTB)
#define PG8_SB(b, h) ((4 + (b) * 2 + (h)) * HTB)
#define PG8_STAGE(bufoff, gbase, voff) do { _Pragma("unroll") for (int _i = 0; _i < 2; ++_i) \
        __builtin_amdgcn_global_load_lds((const unsigned*)((const char*)(gbase) + _i * voff##_step + (voff)), (PG8_LAS unsigned*)(lds + (bufoff) + ldsw + _i * 8192), 16, 0, 0); } while (0)
#define PG8_LD2(p_) cat16(*(const PG8_LAS bf16x8*)(p_), *(const PG8_LAS bf16x8*)((p_) + 1024))
#define PG8_LDA(dst, b, h) do { _Pragma("unroll") for (int m = 0; m < 4; ++m) dst[m].v = PG8_LD2(lds + PG8_SA(b, h) + aoff + m * 2048); } while (0)
    unsigned bbase_ = (unsigned)(uintptr_t)(lds + 4 * HTB) + (unsigned)boff; asm volatile("" : "+v"(bbase_));
    const PG8_LAS unsigned char* const ldsB = (const PG8_LAS unsigned char*)(uintptr_t)bbase_;
#define PG8_LDB(dst, b, h) do { _Pragma("unroll") for (int n = 0; n < 2; ++n) dst[n].v = PG8_LD2(ldsB + ((b) * 2 + (h)) * HTB + n * 2048); } while (0)
#define PG8_HALF(f_, k_) __builtin_bit_cast(bf16x8, (k_) ? __builtin_shufflevector((f_).v, (f_).v, 4, 5, 6, 7) : __builtin_shufflevector((f_).v, (f_).v, 0, 1, 2, 3))
#define PG8_MMA(ai, bj, At, Bt) do { __builtin_amdgcn_s_setprio(1); \
        if constexpr (FP8) { _Pragma("unroll") for (int m = 0; m < 4; ++m) _Pragma("unroll") for (int n = 0; n < 2; ++n) \
            acc[ai][bj][m][n] = __builtin_amdgcn_mfma_scale_f32_16x16x128_f8f6f4(Bt[n].v, At[m].v, acc[ai][bj][m][n], 0, 0, 0, 0, 0, 0); } \
        else { _Pragma("unroll") for (int m = 0; m < 4; ++m) _Pragma("unroll") for (int n = 0; n < 2; ++n) _Pragma("unroll") for (int k = 0; k < 2; ++k) \
            acc[ai][bj][m][n] = __builtin_amdgcn_mfma_f32_16x16x32_bf16(PG8_HALF(Bt[n], k), PG8_HALF(At[m], k), acc[ai][bj][m][n], 0, 0, 0); } \
        __builtin_amdgcn_s_setprio(0); } while (0)
#define PG8_WAIT_V(n) asm volatile("s_waitcnt vmcnt(" #n ")" ::: "memory")
#define PG8_WAIT_L(n) asm volatile("s_waitcnt lgkmcnt(" #n ")" ::: "memory")
#define PG8_BAR __builtin_amdgcn_s_barrier()
#define PG8_SCHED __builtin_amdgcn_sched_barrier(0)
    Unit cur, nxt; int ui = 0;
    if (!S.next(0, cur)) return;
    f32x4 acc[2][2][4][2];
#pragma unroll
    for (int a = 0; a < 2; ++a)
#pragma unroll
        for (int b = 0; b < 2; ++b)
#pragma unroll
            for (int m = 0; m < 4; ++m)
#pragma unroll
                for (int n = 0; n < 2; ++n) acc[a][b][m][n] = (f32x4){0.f, 0.f, 0.f, 0.f};
    Frag2 At[4], B0[2], B1[2];
    const char* cA = (const char*)g.A + (size_t)cur.pm * tstepA; const char* cB = (const char*)g.Bt + (size_t)cur.pn * tstepB;
    S.a_ready(cur);
    PG8_STAGE(PG8_SB(0, 0), cB, voffB); PG8_STAGE(PG8_SA(0, 0), cA, voffA); PG8_STAGE(PG8_SB(0, 1), cB + hstepB, voffB); PG8_STAGE(PG8_SA(0, 1), cA + hstepA, voffA);
    if (wr == 1) PG8_BAR;
    PG8_WAIT_V(4); PG8_BAR;
    PG8_STAGE(PG8_SB(1, 0), cB + kstep, voffB); PG8_STAGE(PG8_SA(1, 0), cA + kstep, voffA); PG8_STAGE(PG8_SB(1, 1), cB + hstepB + kstep, voffB);
    PG8_WAIT_V(6); PG8_BAR;
    for (;;) {
        const bool has_next = S.next(ui + 1, nxt);
        const char* nA = has_next ? (const char*)g.A + (size_t)nxt.pm * tstepA : cA; const char* nB = has_next ? (const char*)g.Bt + (size_t)nxt.pn * tstepB : cB;
        for (int t = 0; t < nt; t += 2) {
            const bool last = (t == nt - 2);
            const char* a1 = cA + (size_t)(t + 1) * kstep;
            const char* a2 = last ? nA : cA + (size_t)(t + 2) * kstep; const char* b2 = last ? nB : cB + (size_t)(t + 2) * kstep;
            const char* a3 = a2 + kstep; const char* b3 = b2 + kstep;
            if (last && has_next) S.a_ready(nxt);
            PG8_LDB(B0, 0, 0); PG8_SCHED; PG8_LDA(At, 0, 0); PG8_STAGE(PG8_SA(1, 1), a1 + hstepA, voffA);
            PG8_WAIT_L(8); PG8_BAR; PG8_WAIT_L(0); PG8_MMA(0, 0, At, B0); PG8_BAR; PG8_SCHED;
            PG8_LDB(B1, 0, 1); PG8_STAGE(PG8_SB(0, 0), b2, voffB);
            PG8_BAR; PG8_WAIT_L(0); PG8_MMA(0, 1, At, B1); PG8_BAR;
            PG8_LDA(At, 0, 1); PG8_STAGE(PG8_SA(0, 0), a2, voffA);
            PG8_BAR; PG8_WAIT_L(0); PG8_MMA(1, 0, At, B0); PG8_BAR; PG8_SCHED;
            PG8_STAGE(PG8_SB(0, 1), b2 + hstepB, voffB);
            PG8_WAIT_V(6); PG8_BAR; PG8_MMA(1, 1, At, B1); PG8_BAR;
            PG8_LDB(B0, 1, 0); PG8_SCHED; PG8_LDA(At, 1, 0); PG8_STAGE(PG8_SA(0, 1), a2 + hstepA, voffA);
            PG8_WAIT_L(8); PG8_BAR; PG8_WAIT_L(0); PG8_MMA(0, 0, At, B0); PG8_BAR; PG8_SCHED;
            PG8_LDB(B1, 1, 1); PG8_STAGE(PG8_SB(1, 0), b3, voffB);
            PG8_BAR; PG8_WAIT_L(0); PG8_MMA(0, 1, At, B1); PG8_BAR;
            PG8_LDA(At, 1, 1); PG8_STAGE(PG8_SA(1, 0), a3, voffA);
            PG8_BAR; PG8_WAIT_L(0); PG8_MMA(1, 0, At, B0); PG8_BAR; PG8_SCHED;
            PG8_STAGE(PG8_SB(1, 1), b3 + hstepB, voffB);
            PG8_WAIT_V(6); PG8_BAR; PG8_MMA(1, 1, At, B1); PG8_BAR;
        }
        if constexpr (!Epi::AFTER_DRAIN) { int le = lane; asm volatile("" : "+v"(le)); E(acc, cur, wr, wc, le & 15, le >> 4); S.done(cur); }
        if (!has_next) break;
#pragma unroll
        for (int a = 0; a < 2; ++a)
#pragma unroll
            for (int b = 0; b < 2; ++b)
#pragma unroll
                for (int m = 0; m < 4; ++m)
#pragma unroll
                    for (int n = 0; n < 2; ++n) acc[a][b][m][n] = (f32x4){0.f, 0.f, 0.f, 0.f};
        cur = nxt; cA = nA; cB = nB; ++ui;
    }
    PG8_WAIT_V(0);
    if (wr == 0) PG8_BAR;
    PG8_BAR;
    if constexpr (Epi::AFTER_DRAIN) { E.fused(acc, cur, wr, wc, fr, fq, lds, wid, lane); S.done(cur); }
#undef PG8_SA
#undef PG8_SB
#undef PG8_STAGE
#undef PG8_LDA
#undef PG8_LD2
#undef PG8_HALF
#undef PG8_LDB
#undef PG8_MMA
#undef PG8_WAIT_V
#undef PG8_WAIT_L
#undef PG8_BAR
#undef PG8_SCHED
}

struct EpiStoreBf16 {
    static constexpr bool PERM = true, AFTER_DRAIN = false;
    bf16_t* O; int ldc;
    __device__ __forceinline__ void operator()(const f32x4 (&acc)[2][2][4][2], const Unit& u, int wr, int wc, int fr, int fq) const {
        const int row0 = u.pm * BM + wr * 64 + fr, col0 = u.pn * BM + wc * 32 + 8 * fq;
#pragma unroll
        for (int ai = 0; ai < 2; ++ai)
#pragma unroll
            for (int m = 0; m < 4; ++m) {
                bf16_t* rowp = O + (size_t)(row0 + ai * HALF + m * 16) * ldc + col0;
#pragma unroll
                for (int bj = 0; bj < 2; ++bj) {
                    const f32x4 v0 = acc[ai][bj][m][0], v1 = acc[ai][bj][m][1];
                    u32x4 w; w.x = cvt_pk_bf16(v0[0], v0[1]); w.y = cvt_pk_bf16(v0[2], v0[3]); w.z = cvt_pk_bf16(v1[0], v1[1]); w.w = cvt_pk_bf16(v1[2], v1[3]);
                    *(u32x4*)(rowp + bj * HALF) = w;
                }
            }
    }
};

__device__ __forceinline__ void cvt_table_bf16(const float* __restrict__ src, bf16_t* __restrict__ dst, size_t n8, const int g_wave) {
    const size_t stride = (size_t)gridDim.x * 512;
    for (size_t i = (size_t)blockIdx.x * 512 + MYTID; i < n8; i += stride) {
        const f32x4 a = *(const f32x4*)(src + i * 8), b = *(const f32x4*)(src + i * 8 + 4);
        u32x4 w; w.x = cvt_pk_bf16(a[0], a[1]); w.y = cvt_pk_bf16(a[2], a[3]); w.z = cvt_pk_bf16(b[0], b[1]); w.w = cvt_pk_bf16(b[2], b[3]);
        *(u32x4*)(dst + i * 8) = w;
    }
}

template <int MODE>
__device__ __forceinline__ void transpose_task(const float* __restrict__ W, int ldw, int K, int Nvalid, int Npad, const float* __restrict__ rs,
                                               bf16_t* __restrict__ Wt, float* tile, int rot, const int g_wave) {
    const int tk = K / 64, tn = Npad / 64, nt = tk * tn, tid = MYTID, G = gridDim.x;
    const int start = (int)((blockIdx.x + (unsigned)rot) % (unsigned)G);
    for (int u = start; u < nt; u += G) {
        const int k0 = (u % tk) * 64, n0 = (u / tk) * 64;
        __syncthreads();
#pragma unroll
        for (int i = 0; i < 8; ++i) {
            const int kk = (tid >> 6) + 8 * i, nn = tid & 63, n = n0 + nn;
            float v = 0.f;
            if (n < Nvalid) {
                const int col = (MODE == 0) ? n : ((n >> 6) * 128 + (MODE == 2 ? 64 : 0) + (n & 63));
                v = W[(size_t)(k0 + kk) * ldw + col];
                if (rs) v *= rs[k0 + kk];
            }
            tile[kk * 65 + nn] = v;
        }
        __syncthreads();
        {
            const int nn = tid >> 3, kc = (tid & 7) * 8;
            float v[8];
#pragma unroll
            for (int e = 0; e < 8; ++e) v[e] = tile[(kc + e) * 65 + nn];
            u32x4 w; w.x = cvt_pk_bf16(v[0], v[1]); w.y = cvt_pk_bf16(v[2], v[3]); w.z = cvt_pk_bf16(v[4], v[5]); w.w = cvt_pk_bf16(v[6], v[7]);
            *(u32x4*)(Wt + (size_t)(n0 + nn) * K + k0 + kc) = w;
        }
    }
}

template <bool SIGNED> __device__ __forceinline__ void cvt_table_i8(const float* __restrict__ src, unsigned char* __restrict__ dst, float* __restrict__ scales, int nrows, const int g_wave);
__device__ __forceinline__ void ph_filt_mlp(const MP& p, unsigned char* smem, const int g_wave);
__device__ __forceinline__ void ph_prep(const MP& p, unsigned char* smem, const int g_wave) {
    const int tid = MYTID, bid = blockIdx.x, G = gridDim.x;
    unsigned char* ws = p.ws;
    if (bid < 192) {
        float* sc = (float*)smem;
        float* red = (float*)(smem + 36864);
        const float* c = p.in[1]; const float* c_ctx = p.in[3]; const float* mod_w = p.in[4]; const float* mod_b = p.in[5];
        float* modv = (float*)(ws + WS_MODV);
        for (int e = tid; e < 9 * 1024; e += 512) {
            const int r = e >> 10, k = e & 1023;
            const float v = (r < 8) ? c[r * 1024 + k] : c_ctx[k];
            sc[e] = v / (1.f + __expf(-v));
        }
        __syncthreads();
        for (int u = bid; u < 192; u += G) {
            const int i = u / 96, j0 = (u % 96) * 64, col = tid & 63, kg = tid >> 6;
            float acc[9];
#pragma unroll
            for (int r = 0; r < 9; ++r) acc[r] = 0.f;
            const float* wp = mod_w + ((size_t)i * 1024 + kg * 128) * 6144 + j0 + col;
#pragma unroll 4
            for (int k = 0; k < 128; ++k) {
                const float w = wp[(size_t)k * 6144];
#pragma unroll
                for (int r = 0; r < 9; ++r) acc[r] += sc[r * 1024 + kg * 128 + k] * w;
            }
#pragma unroll
            for (int r = 0; r < 9; ++r) red[(kg * 9 + r) * 64 + col] = acc[r];
            __syncthreads();
            for (int e = tid; e < 9 * 64; e += 512) {
                const int r = e >> 6, cc = e & 63;
                float s = 0.f;
#pragma unroll
                for (int g8 = 0; g8 < 8; ++g8) s += red[(g8 * 9 + r) * 64 + cc];
                modv[((size_t)i * 9 + r) * 6144 + j0 + cc] = s + mod_b[i * 6144 + j0 + cc];
            }
            __syncthreads();
        }
    }
    __syncthreads();
    float* tile = (float*)smem;
    transpose_task<0>(p.in[9], DLAT, 1024, DLAT, 768, nullptr, (bf16_t*)(ws + WS_WDKV), tile, 64, g_wave);
    transpose_task<0>(p.in[11], 1536, QLORA, 1536, 1536, p.in[10], (bf16_t*)(ws + WS_WUQ), tile, 0, g_wave);
    transpose_task<1>(p.in[13], 2048, KVLORA, 1024, 1024, p.in[12], (bf16_t*)(ws + WS_WK), tile, 144, g_wave);
    transpose_task<2>(p.in[13], 2048, KVLORA, 1024, 1024, p.in[12], (bf16_t*)(ws + WS_WV), tile, 208, g_wave);
    transpose_task<0>(p.in[14], 1024, 1024, 1024, 1024, nullptr, (bf16_t*)(ws + WS_WO), tile, 16, g_wave);
    transpose_task<0>(p.in[29], 2048, 1024, 2048, 2048, nullptr, (bf16_t*)(ws + WS_WQ), tile, 32, g_wave);
    transpose_task<0>(p.in[29] + (size_t)1024 * 2048, 2048, 1024, 2048, 2048, nullptr, (bf16_t*)(ws + WS_WQ) + (size_t)2048 * 1024, tile, 96, g_wave);
    transpose_task<0>(p.in[15], 3072, 1024, 3072, 3072, nullptr, (bf16_t*)(ws + WS_WIN), tile, 160, g_wave);
    transpose_task<0>(p.in[28], 1024, 1024, 1024, 1024, nullptr, (bf16_t*)(ws + WS_WOUT), tile, 224, g_wave);
    cvt_table_bf16(p.in[30], (bf16_t*)(ws + WS_KEYS), (size_t)2 * 16 * 128 * 128 / 8, g_wave);
    for (int L = 0; L < 2; ++L) {
        cvt_table_i8<true>(p.in[31] + (size_t)L * 16384 * 1024, ws + WS_PT + (size_t)L * 32 * MiB, (float*)(ws + WS_PSC) + L * 32768, 16384, g_wave);
        cvt_table_i8<false>(p.in[32] + (size_t)L * 16384 * 1024, ws + WS_PT + (size_t)L * 32 * MiB + 16 * MiB, (float*)(ws + WS_PSC) + L * 32768 + 16384, 16384, g_wave);
    }
    {
        float* rope = (float*)(ws + WS_ROPE);
        for (int e = bid * 512 + tid; e < 4096 * 16; e += G * 512) {
            const int t = e >> 4, i = e & 15;
            const float inv = powf(10000.f, -(float)(i & 7) / 8.f);
            const float pos = (i < 8) ? (float)(t / 64) : (float)(t % 64);
            const float a = pos * inv;
            rope[t * 32 + i] = cosf(a);
            rope[t * 32 + 16 + i] = sinf(a);
        }
    }
    ph_filt_mlp(p, smem, g_wave);
    for (int e = bid * 512 + tid; e < 2048; e += G * 512) {
        ((float*)(ws + WS_FNORM))[e] = 0.f;
        ((bf16_t*)(ws + WS_FILT))[(size_t)e * 8192] = 0;
    }
}

template <int MODE>
__device__ __forceinline__ void ph_normmod(const float* __restrict__ xlat, const float* __restrict__ xctx, const float* __restrict__ g,
                                           const float* __restrict__ modl  , int shift_chunk, bf16_t* __restrict__ Hb, const int g_wave) {
    const int lane = lane_id(), wid = g_wave;
    const int nrows = (MODE == 0) ? NROW : NTOK;
    for (int row = blockIdx.x * 8 + wid; row < nrows; row += gridDim.x * 8) {
        const float* src; int mr;
        if (MODE == 0) {
            const int b = row / RPB, r = row - b * RPB;
            if (r < SEQ) { src = xlat + ((size_t)b * SEQ + r) * 1024; mr = b; }
            else { src = xctx + ((size_t)b * CTXL + (r - SEQ)) * 1024; mr = 8; }
        } else { src = nullptr; mr = row >> 12; }
        const float* shift = modl + (size_t)mr * 6144 + shift_chunk * 1024;
        const float* scale = shift + 1024;
        f32x4 v[4];
        float ss = 0.f;
#pragma unroll
        for (int c = 0; c < 4; ++c) {
            if (MODE == 0) v[c] = *(const f32x4*)(src + c * 256 + lane * 4);
            else { const u32x2 w = *(const u32x2*)((const bf16_t*)xlat + (size_t)row * 1024 + c * 256 + lane * 4); v[c] = (f32x4){bflo(w.x), bfhi(w.x), bflo(w.y), bfhi(w.y)}; }
            ss += v[c][0] * v[c][0] + v[c][1] * v[c][1] + v[c][2] * v[c][2] + v[c][3] * v[c][3];
        }
        ss = warp_sum(ss);
        const float rs = rsqrtf(ss * (1.f / 1024.f) + 1e-6f);
#pragma unroll
        for (int c = 0; c < 4; ++c) {
            const int j = c * 256 + lane * 4;
            const f32x4 gg = *(const f32x4*)(g + j), sh = *(const f32x4*)(shift + j), scl = *(const f32x4*)(scale + j);
            float y[4];
#pragma unroll
            for (int e = 0; e < 4; ++e) y[e] = v[c][e] * rs * gg[e] * (1.f + scl[e]) + sh[e];
            u32x2 w; w.x = cvt_pk_bf16(y[0], y[1]); w.y = cvt_pk_bf16(y[2], y[3]);
            *(u32x2*)(Hb + (size_t)row * 1024 + j) = w;
        }
    }
}

__device__ __forceinline__ void ph_latpost(const bf16_t* __restrict__ LATb, const float* __restrict__ rope, float* __restrict__ RQ,
                                           float* __restrict__ RK, bf16_t* __restrict__ KRb, const int g_wave) {
    const int lane = lane_id(), wid = g_wave;
    for (int row = blockIdx.x * 8 + wid; row < NROW; row += gridDim.x * 8) {
        const bf16_t* l = LATb + (size_t)row * 768;
        float sq = 0.f, sk = 0.f;
        if (lane < 48) {
            const u32x4 w = *(const u32x4*)(l + lane * 8);
#pragma unroll
            for (int e = 0; e < 4; ++e) { const float a = bflo(w[e]), b = bfhi(w[e]); sq += a * a + b * b; }
        }
        if (lane < 32) {
            const u32x4 w = *(const u32x4*)(l + QLORA + lane * 8);
#pragma unroll
            for (int e = 0; e < 4; ++e) { const float a = bflo(w[e]), b = bfhi(w[e]); sk += a * a + b * b; }
        }
        sq = warp_sum(sq); sk = warp_sum(sk);
        float xv[8];
        {
            const u32x4 w = *(const u32x4*)(l + 640 + (lane & 3) * 8);
#pragma unroll
            for (int e = 0; e < 4; ++e) { xv[2 * e] = bflo(w[e]); xv[2 * e + 1] = bfhi(w[e]); }
        }
        const int b = row / RPB, r = row - b * RPB;
        float ov[8];
        if (r < SEQ) {
            const float* cs = rope + (size_t)r * 32 + ((lane >> 1) & 1) * 8;
            const float sgn = (lane & 1) ? 1.f : -1.f;
#pragma unroll
            for (int j = 0; j < 8; ++j) {
                const float pv = __shfl_xor(xv[j], 1);
                ov[j] = xv[j] * cs[j] + sgn * pv * cs[16 + j];
            }
        } else {
#pragma unroll
            for (int j = 0; j < 8; ++j) ov[j] = xv[j];
        }
        if (lane < 4) {
            u32x4 w; w.x = cvt_pk_bf16(ov[0], ov[1]); w.y = cvt_pk_bf16(ov[2], ov[3]); w.z = cvt_pk_bf16(ov[4], ov[5]); w.w = cvt_pk_bf16(ov[6], ov[7]);
            *(u32x4*)(KRb + (size_t)row * 32 + lane * 8) = w;
        }
        if (lane == 0) { RQ[row] = rsqrtf(sq * (1.f / 384.f) + 1e-6f); RK[row] = rsqrtf(sk * (1.f / 256.f) + 1e-6f); }
    }
}

constexpr float QSCALE = 0.10206207261596575f * 1.4426950408889634f;
struct EpiQ {
    static constexpr bool PERM = true, AFTER_DRAIN = false;
    bf16_t* Qb; const float* RQ; const float* rope;
    __device__ __forceinline__ void operator()(const f32x4 (&acc)[2][2][4][2], const Unit& u, int wr, int wc, int fr, int fq) const {
        const int b = u.pm / 17, tt = (u.pm - b * 17) * BM + wr * 64 + fr;
        const float* rqp = RQ + (size_t)b * RPB + tt;
        bf16_t* qp = Qb + ((size_t)b * SEQ + tt) * 1536 + 8 * fq;
        const float* cs0 = rope + (size_t)tt * 32 + (fq >> 1) * 8;
        const float sgn = (fq & 1) ? 1.f : -1.f;
#pragma unroll
        for (int ai = 0; ai < 2; ++ai)
#pragma unroll
            for (int m = 0; m < 4; ++m) {
                const int dr = ai * HALF + m * 16;
                const float sc = rqp[dr] * QSCALE;
#pragma unroll
                for (int bj = 0; bj < 2; ++bj) {
                    const int g32 = u.pn * 8 + bj * 4 + wc;
                    float v[8];
#pragma unroll
                    for (int e = 0; e < 4; ++e) { v[e] = acc[ai][bj][m][0][e] * sc; v[4 + e] = acc[ai][bj][m][1][e] * sc; }
                    if (g32 % 3 == 2) {
                        const float* cs = cs0 + (size_t)dr * 32;
#pragma unroll
                        for (int j = 0; j < 8; ++j) {
                            const float pv = __shfl_xor(v[j], 16);
                            v[j] = v[j] * cs[j] + sgn * pv * cs[16 + j];
                        }
                    }
                    u32x4 w; w.x = cvt_pk_bf16(v[0], v[1]); w.y = cvt_pk_bf16(v[2], v[3]); w.z = cvt_pk_bf16(v[4], v[5]); w.w = cvt_pk_bf16(v[6], v[7]);
                    *(u32x4*)(qp + (size_t)dr * 1536 + g32 * 32) = w;
                }
            }
    }
};
struct EpiRowScale {
    static constexpr bool PERM = true, AFTER_DRAIN = false;
    bf16_t* O; int ldc; const float* rs;
    __device__ __forceinline__ void operator()(const f32x4 (&acc)[2][2][4][2], const Unit& u, int wr, int wc, int fr, int fq) const {
        const int row0 = u.pm * BM + wr * 64 + fr, col0 = u.pn * BM + wc * 32 + 8 * fq;
#pragma unroll
        for (int ai = 0; ai < 2; ++ai)
#pragma unroll
            for (int m = 0; m < 4; ++m) {
                const int row = row0 + ai * HALF + m * 16;
                const float sc = rs[row];
                bf16_t* rowp = O + (size_t)row * ldc + col0;
#pragma unroll
                for (int bj = 0; bj < 2; ++bj) {
                    const f32x4 v0 = acc[ai][bj][m][0] * sc, v1 = acc[ai][bj][m][1] * sc;
                    u32x4 w; w.x = cvt_pk_bf16(v0[0], v0[1]); w.y = cvt_pk_bf16(v0[2], v0[3]); w.z = cvt_pk_bf16(v1[0], v1[1]); w.w = cvt_pk_bf16(v1[2], v1[3]);
                    *(u32x4*)(rowp + bj * HALF) = w;
                }
            }
    }
};
struct EpiColScale {
    static constexpr bool PERM = true, AFTER_DRAIN = false;
    bf16_t* O; int ldc; const float* cs;
    __device__ __forceinline__ void operator()(const f32x4 (&acc)[2][2][4][2], const Unit& u, int wr, int wc, int fr, int fq) const {
        const int row0 = u.pm * BM + wr * 64 + fr, col0 = u.pn * BM + wc * 32 + 8 * fq;
#pragma unroll
        for (int bj = 0; bj < 2; ++bj) {
            const f32x4 s0 = *(const f32x4*)(cs + col0 + bj * HALF), s1 = *(const f32x4*)(cs + col0 + bj * HALF + 4);
            bf16_t* colp = O + (size_t)row0 * ldc + col0 + bj * HALF;
#pragma unroll
            for (int ai = 0; ai < 2; ++ai)
#pragma unroll
                for (int m = 0; m < 4; ++m) {
                    const f32x4 v0 = acc[ai][bj][m][0] * s0, v1 = acc[ai][bj][m][1] * s1;
                    u32x4 w; w.x = cvt_pk_bf16(v0[0], v0[1]); w.y = cvt_pk_bf16(v0[2], v0[3]); w.z = cvt_pk_bf16(v1[0], v1[1]); w.w = cvt_pk_bf16(v1[2], v1[3]);
                    *(u32x4*)(colp + (size_t)(ai * HALF + m * 16) * ldc) = w;
                }
        }
    }
};
__device__ __forceinline__ void ph_win8(const bf16_t* __restrict__ W, unsigned char* __restrict__ W8, float* __restrict__ rs, const int g_wave) {
    const int lane = lane_id(), wid = g_wave;
    for (int row = blockIdx.x * 8 + wid; row < 3072; row += gridDim.x * 8) {
        const u32x4 a = *(const u32x4*)(W + (size_t)row * 1024 + lane * 16), b = *(const u32x4*)(W + (size_t)row * 1024 + lane * 16 + 8);
        float v[16];
#pragma unroll
        for (int c = 0; c < 4; ++c) { v[2 * c] = bflo(a[c]); v[2 * c + 1] = bfhi(a[c]); v[8 + 2 * c] = bflo(b[c]); v[8 + 2 * c + 1] = bfhi(b[c]); }
        float mx = 0.f;
#pragma unroll
        for (int i = 0; i < 16; ++i) mx = fmaxf(mx, fabsf(v[i]));
#pragma unroll
        for (int o = 32; o > 0; o >>= 1) mx = fmaxf(mx, __shfl_xor(mx, o));
        mx = fmaxf(mx, 1e-30f);
        const float sc = 256.f / mx;
        u32x4 w;
#pragma unroll
        for (int c = 0; c < 4; ++c) {
            int pk = __builtin_amdgcn_cvt_pk_fp8_f32(v[4 * c] * sc, v[4 * c + 1] * sc, 0, false);
            pk = __builtin_amdgcn_cvt_pk_fp8_f32(v[4 * c + 2] * sc, v[4 * c + 3] * sc, pk, true);
            w[c] = (unsigned)pk;
        }
        *(u32x4*)(W8 + (size_t)row * 1024 + lane * 16) = w;
        if (lane == 0) rs[row] = mx * (1.f / 256.f);
    }
}
template <bool XIN_F32> struct EpiResid {
    static constexpr bool PERM = false, AFTER_DRAIN = false;
    bf16_t* Xo; const void* xin; const float* gate;
    __device__ __forceinline__ void operator()(const f32x4 (&acc)[2][2][4][2], const Unit& u, int wr, int wc, int fr, int fq) const {
        const int row0 = u.pm * BM + wr * 64 + fr, col0 = u.pn * BM + wc * 32 + 4 * fq;
        const float* gp = gate + (size_t)(row0 >> 12) * 6144 + col0;
        f32x4 gv[2][2];
#pragma unroll
        for (int bj = 0; bj < 2; ++bj)
#pragma unroll
            for (int n = 0; n < 2; ++n) gv[bj][n] = *(const f32x4*)(gp + bj * HALF + n * 16);
#pragma unroll
        for (int ai = 0; ai < 2; ++ai)
#pragma unroll
            for (int m = 0; m < 4; ++m) {
                const size_t ro = (size_t)(row0 + ai * HALF + m * 16) * 1024 + col0;
#pragma unroll
                for (int bj = 0; bj < 2; ++bj)
#pragma unroll
                    for (int n = 0; n < 2; ++n) {
                        f32x4 xv;
                        if (XIN_F32) xv = *(const f32x4*)((const float*)xin + ro + bj * HALF + n * 16);
                        else { const u32x2 w = *(const u32x2*)((const bf16_t*)xin + ro + bj * HALF + n * 16); xv = (f32x4){bflo(w.x), bfhi(w.x), bflo(w.y), bfhi(w.y)}; }
                        const f32x4 o = xv + gv[bj][n] * acc[ai][bj][m][n];
                        u32x2 ow; ow.x = cvt_pk_bf16(o[0], o[1]); ow.y = cvt_pk_bf16(o[2], o[3]);
                        *(u32x2*)(Xo + ro + bj * HALF + n * 16) = ow;
                    }
            }
    }
};

constexpr int AT_KSTR = 208, AT_VSTR = 144, AT_KBYTES = 64 * AT_KSTR, AT_BUF = 64 * AT_KSTR + 64 * AT_VSTR;
constexpr int AT_NT = RPB / 64;
struct AtStage { u32x4 k, v, r; };
__device__ __forceinline__ void at_tile(const unsigned char* kb, const bf16x8 (&qf)[6], int r, int hh, f32x16& o0, f32x16& o1, float& mrun, float& lrun, const bool first) {
    const unsigned char* vb = kb + AT_KBYTES;
    bf16x8 kfa[6], kfb[6];
#pragma unroll
    for (int ks = 0; ks < 6; ++ks) {
        kfa[ks] = *(const bf16x8*)(kb + r * AT_KSTR + ks * 32 + hh * 16);
        kfb[ks] = *(const bf16x8*)(kb + (32 + r) * AT_KSTR + ks * 32 + hh * 16);
    }
    __builtin_amdgcn_sched_barrier(0);
    f32x16 s0, s1;
    {
        const float nm = -mrun;
#pragma unroll
        for (int e = 0; e < 16; ++e) { s0[e] = nm; s1[e] = nm; }
    }
#pragma unroll
    for (int ks = 0; ks < 6; ++ks) {
        s0 = __builtin_amdgcn_mfma_f32_32x32x16_bf16(kfa[ks], qf[ks], s0, 0, 0, 0);
        s1 = __builtin_amdgcn_mfma_f32_32x32x16_bf16(kfb[ks], qf[ks], s1, 0, 0, 0);
    }
    bf16x8 vfa[4], vfb[4];
#pragma unroll
    for (int ks = 0; ks < 4; ++ks) {
        vfa[ks] = *(const bf16x8*)(vb + r * AT_VSTR + ks * 32 + hh * 16);
        vfb[ks] = *(const bf16x8*)(vb + (32 + r) * AT_VSTR + ks * 32 + hh * 16);
    }
    __builtin_amdgcn_sched_barrier(0);
    float mx = s0[0];
#pragma unroll
    for (int e = 1; e < 16; ++e) mx = fmaxf(mx, s0[e]);
#pragma unroll
    for (int e = 0; e < 16; ++e) mx = fmaxf(mx, s1[e]);
    mx = fmaxf(mx, __shfl_xor(mx, 32));
    if (first || !__all(mx <= 8.f)) {
        const float dm = first ? mx : fmaxf(mx, 0.f);
        const float alpha = first ? 1.f : __builtin_amdgcn_exp2f(-dm);
        mrun += dm; lrun *= alpha;
#pragma unroll
        for (int e = 0; e < 16; ++e) { o0[e] *= alpha; o1[e] *= alpha; s0[e] -= dm; s1[e] -= dm; }
    }
    float ps = 0.f;
#pragma unroll
    for (int e = 0; e < 16; ++e) { s0[e] = __builtin_amdgcn_exp2f(s0[e]); ps += s0[e]; }
#pragma unroll
    for (int e = 0; e < 16; ++e) { s1[e] = __builtin_amdgcn_exp2f(s1[e]); ps += s1[e]; }
    bf16x8 pb[4];
#pragma unroll
    for (int s = 0; s < 2; ++s) {
        u32x4 w0, w1;
        w0.x = cvt_pk_bf16(s0[8 * s + 0], s0[8 * s + 1]); w0.y = cvt_pk_bf16(s0[8 * s + 2], s0[8 * s + 3]);
        w0.z = cvt_pk_bf16(s0[8 * s + 4], s0[8 * s + 5]); w0.w = cvt_pk_bf16(s0[8 * s + 6], s0[8 * s + 7]);
        w1.x = cvt_pk_bf16(s1[8 * s + 0], s1[8 * s + 1]); w1.y = cvt_pk_bf16(s1[8 * s + 2], s1[8 * s + 3]);
        w1.z = cvt_pk_bf16(s1[8 * s + 4], s1[8 * s + 5]); w1.w = cvt_pk_bf16(s1[8 * s + 6], s1[8 * s + 7]);
        pb[s] = __builtin_bit_cast(bf16x8, w0); pb[2 + s] = __builtin_bit_cast(bf16x8, w1);
    }
    lrun += ps;
#pragma unroll
    for (int ks = 0; ks < 4; ++ks) {
        o0 = __builtin_amdgcn_mfma_f32_32x32x16_bf16(vfa[ks], pb[ks], o0, 0, 0, 0);
        o1 = __builtin_amdgcn_mfma_f32_32x32x16_bf16(vfb[ks], pb[ks], o1, 0, 0, 0);
    }
}
__device__ __forceinline__ void at_pair(const unsigned char* kbA, const unsigned char* kbB, const bf16x8 (&qf)[6], int r, int hh, f32x16& o0, f32x16& o1, float& mrun, float& lrun, const bool first) {
    const unsigned char* vbA = kbA + AT_KBYTES; const unsigned char* vbB = kbB + AT_KBYTES;
    f32x16 a0, a1;
    {
        const float nm = -mrun;
#pragma unroll
        for (int e = 0; e < 16; ++e) { a0[e] = nm; a1[e] = nm; }
    }
#pragma unroll
    for (int ks = 0; ks < 6; ++ks) {
        const bf16x8 ka = *(const bf16x8*)(kbA + r * AT_KSTR + ks * 32 + hh * 16), kb2 = *(const bf16x8*)(kbA + (32 + r) * AT_KSTR + ks * 32 + hh * 16);
        a0 = __builtin_amdgcn_mfma_f32_32x32x16_bf16(ka, qf[ks], a0, 0, 0, 0);
        a1 = __builtin_amdgcn_mfma_f32_32x32x16_bf16(kb2, qf[ks], a1, 0, 0, 0);
    }
    {
        float mx = a0[0];
#pragma unroll
        for (int e = 1; e < 16; ++e) mx = fmaxf(mx, a0[e]);
#pragma unroll
        for (int e = 0; e < 16; ++e) mx = fmaxf(mx, a1[e]);
        mx = fmaxf(mx, __shfl_xor(mx, 32));
        if (first || !__all(mx <= 8.f)) {
            const float dm = first ? mx : fmaxf(mx, 0.f);
            const float alpha = first ? 1.f : __builtin_amdgcn_exp2f(-dm);
            mrun += dm; lrun *= alpha;
#pragma unroll
            for (int e = 0; e < 16; ++e) { o0[e] *= alpha; o1[e] *= alpha; a0[e] -= dm; a1[e] -= dm; }
        }
    }
    f32x16 b0, b1;
    {
        const float nm = -mrun;
#pragma unroll
        for (int e = 0; e < 16; ++e) { b0[e] = nm; b1[e] = nm; }
    }
#pragma unroll
    for (int ks = 0; ks < 6; ++ks) {
        const bf16x8 ka = *(const bf16x8*)(kbB + r * AT_KSTR + ks * 32 + hh * 16), kb2 = *(const bf16x8*)(kbB + (32 + r) * AT_KSTR + ks * 32 + hh * 16);
        b0 = __builtin_amdgcn_mfma_f32_32x32x16_bf16(ka, qf[ks], b0, 0, 0, 0);
        b1 = __builtin_amdgcn_mfma_f32_32x32x16_bf16(kb2, qf[ks], b1, 0, 0, 0);
    }
    bf16x8 pb[4];
    {
        float ps = 0.f;
#pragma unroll
        for (int e = 0; e < 16; ++e) { a0[e] = __builtin_amdgcn_exp2f(a0[e]); ps += a0[e]; }
#pragma unroll
        for (int e = 0; e < 16; ++e) { a1[e] = __builtin_amdgcn_exp2f(a1[e]); ps += a1[e]; }
#pragma unroll
        for (int s = 0; s < 2; ++s) {
            u32x4 w0, w1;
            w0.x = cvt_pk_bf16(a0[8 * s + 0], a0[8 * s + 1]); w0.y = cvt_pk_bf16(a0[8 * s + 2], a0[8 * s + 3]);
            w0.z = cvt_pk_bf16(a0[8 * s + 4], a0[8 * s + 5]); w0.w = cvt_pk_bf16(a0[8 * s + 6], a0[8 * s + 7]);
            w1.x = cvt_pk_bf16(a1[8 * s + 0], a1[8 * s + 1]); w1.y = cvt_pk_bf16(a1[8 * s + 2], a1[8 * s + 3]);
            w1.z = cvt_pk_bf16(a1[8 * s + 4], a1[8 * s + 5]); w1.w = cvt_pk_bf16(a1[8 * s + 6], a1[8 * s + 7]);
            pb[s] = __builtin_bit_cast(bf16x8, w0); pb[2 + s] = __builtin_bit_cast(bf16x8, w1);
        }
        lrun += ps;
    }
#pragma unroll
    for (int ks = 0; ks < 4; ++ks) {
        const bf16x8 va = *(const bf16x8*)(vbA + r * AT_VSTR + ks * 32 + hh * 16), vb2 = *(const bf16x8*)(vbA + (32 + r) * AT_VSTR + ks * 32 + hh * 16);
        o0 = __builtin_amdgcn_mfma_f32_32x32x16_bf16(va, pb[ks], o0, 0, 0, 0);
        o1 = __builtin_amdgcn_mfma_f32_32x32x16_bf16(vb2, pb[ks], o1, 0, 0, 0);
    }
    {
        float mx = b0[0];
#pragma unroll
        for (int e = 1; e < 16; ++e) mx = fmaxf(mx, b0[e]);
#pragma unroll
        for (int e = 0; e < 16; ++e) mx = fmaxf(mx, b1[e]);
        mx = fmaxf(mx, __shfl_xor(mx, 32));
        if (!__all(mx <= 8.f)) {
            const float dm = fmaxf(mx, 0.f);
            const float alpha = __builtin_amdgcn_exp2f(-dm);
            mrun += dm; lrun *= alpha;
#pragma unroll
            for (int e = 0; e < 16; ++e) { o0[e] *= alpha; o1[e] *= alpha; b0[e] -= dm; b1[e] -= dm; }
        }
    }
    {
        float ps = 0.f;
#pragma unroll
        for (int e = 0; e < 16; ++e) { b0[e] = __builtin_amdgcn_exp2f(b0[e]); ps += b0[e]; }
#pragma unroll
        for (int e = 0; e < 16; ++e) { b1[e] = __builtin_amdgcn_exp2f(b1[e]); ps += b1[e]; }
#pragma unroll
        for (int s = 0; s < 2; ++s) {
            u32x4 w0, w1;
            w0.x = cvt_pk_bf16(b0[8 * s + 0], b0[8 * s + 1]); w0.y = cvt_pk_bf16(b0[8 * s + 2], b0[8 * s + 3]);
            w0.z = cvt_pk_bf16(b0[8 * s + 4], b0[8 * s + 5]); w0.w = cvt_pk_bf16(b0[8 * s + 6], b0[8 * s + 7]);
            w1.x = cvt_pk_bf16(b1[8 * s + 0], b1[8 * s + 1]); w1.y = cvt_pk_bf16(b1[8 * s + 2], b1[8 * s + 3]);
            w1.z = cvt_pk_bf16(b1[8 * s + 4], b1[8 * s + 5]); w1.w = cvt_pk_bf16(b1[8 * s + 6], b1[8 * s + 7]);
            pb[s] = __builtin_bit_cast(bf16x8, w0); pb[2 + s] = __builtin_bit_cast(bf16x8, w1);
        }
        lrun += ps;
    }
#pragma unroll
    for (int ks = 0; ks < 4; ++ks) {
        const bf16x8 va = *(const bf16x8*)(vbB + r * AT_VSTR + ks * 32 + hh * 16), vb2 = *(const bf16x8*)(vbB + (32 + r) * AT_VSTR + ks * 32 + hh * 16);
        o0 = __builtin_amdgcn_mfma_f32_32x32x16_bf16(va, pb[ks], o0, 0, 0, 0);
        o1 = __builtin_amdgcn_mfma_f32_32x32x16_bf16(vb2, pb[ks], o1, 0, 0, 0);
    }
}
__device__ __forceinline__ void ph_attn(const bf16_t* __restrict__ Qb, const bf16_t* __restrict__ Kb, const bf16_t* __restrict__ KRb,
                                        const bf16_t* __restrict__ VT, bf16_t* __restrict__ Ob, unsigned char* smem, const int g_wave) {
    const int tid = MYTID, lane = tid & 63, wid = g_wave, r = lane & 31, hh = lane >> 5;
    const int bid = blockIdx.x, xcd = bid & 7, local = bid >> 3;
    const int skey = tid >> 3, sch = tid & 7;
    const int rkey = tid >> 2, rch = tid & 3;
    const bool rk = tid < 256;
    const int vslot0 = ((sch & 1) ? 1 : 0), vslot1 = ((sch & 1) ? 3 : 2);
    const int koff = skey * AT_KSTR + sch * 16, kroff = rkey * AT_KSTR + 128 + rch * 16;
    const int voff0 = AT_KBYTES + skey * AT_VSTR + (sch >> 1) * 32 + vslot0 * 8, voff1 = AT_KBYTES + skey * AT_VSTR + (sch >> 1) * 32 + vslot1 * 8;
#define AT_LOAD(S, t) do { (S).k = *(const u32x4*)(kbase + (size_t)(t) * 64 * 1024); (S).v = *(const u32x4*)(vbase + (t) * 64); \
                           if (rk) (S).r = *(const u32x4*)(krbase + (size_t)(t) * 64 * 32); } while (0)
#define AT_WRITE(S, buf) do { unsigned char* _b = smem + (buf) * AT_BUF; *(u32x4*)(_b + koff) = (S).k; if (rk) *(u32x4*)(_b + kroff) = (S).r; \
                              *(u32x2*)(_b + voff0) = (u32x2){(S).v.x, (S).v.y}; *(u32x2*)(_b + voff1) = (u32x2){(S).v.z, (S).v.w}; } while (0)
    for (int i = 0; i < 8; ++i) {
        const int bh = i * 16 + xcd * 2 + (local >> 4), qblk = local & 15;
        const int b = bh >> 4, h = bh & 15;
        const int t0 = qblk * 256 + wid * 32;
        bf16x8 qf[6];
        {
            const bf16_t* qp = Qb + ((size_t)b * SEQ + t0 + r) * 1536 + h * 96 + hh * 8;
#pragma unroll
            for (int ks = 0; ks < 6; ++ks) qf[ks] = *(const bf16x8*)(qp + ks * 16);
        }
        const bf16_t* kbase = Kb + ((size_t)b * RPB + skey) * 1024 + h * 64 + sch * 8;
        const bf16_t* krbase = KRb + ((size_t)b * RPB + rkey) * 32 + rch * 8;
        const bf16_t* vbase = VT + ((size_t)h * 64 + skey) * NROW + (size_t)b * RPB + sch * 8;
        AtStage SA, SB;
        AT_LOAD(SA, 0);
        AT_LOAD(SB, 1);
        AT_WRITE(SA, 0);
        AT_WRITE(SB, 1);
        __syncthreads();
        f32x16 o0 = {}, o1 = {};
        float mrun = 0.f, lrun = 0.f;
        for (int kt = 0; kt < AT_NT; kt += 2) {
            const bool more = (kt + 2 < AT_NT);
            if (more) { AT_LOAD(SA, kt + 2); AT_LOAD(SB, kt + 3); }
            at_pair(smem + (kt & 3) * AT_BUF, smem + ((kt + 1) & 3) * AT_BUF, qf, r, hh, o0, o1, mrun, lrun, kt == 0);
            if (more) { AT_WRITE(SA, (kt + 2) & 3); AT_WRITE(SB, (kt + 3) & 3); }
            __syncthreads();
        }
        const float ltot = lrun + __shfl_xor(lrun, 32);
        const float inv = 1.f / ltot;
        bf16_t* op = Ob + ((size_t)b * SEQ + t0 + r) * 1024 + h * 64 + 4 * hh;
#pragma unroll
        for (int g4 = 0; g4 < 4; ++g4) {
            u32x2 w0, w1;
            w0.x = cvt_pk_bf16(o0[4 * g4 + 0] * inv, o0[4 * g4 + 1] * inv); w0.y = cvt_pk_bf16(o0[4 * g4 + 2] * inv, o0[4 * g4 + 3] * inv);
            w1.x = cvt_pk_bf16(o1[4 * g4 + 0] * inv, o1[4 * g4 + 1] * inv); w1.y = cvt_pk_bf16(o1[4 * g4 + 2] * inv, o1[4 * g4 + 3] * inv);
            *(u32x2*)(op + 8 * g4) = w0;
            *(u32x2*)(op + 32 + 8 * g4) = w1;
        }
    }
#undef AT_LOAD
#undef AT_WRITE
}

template <int LB> __device__ __forceinline__ unsigned mk_key(float s, unsigned payload) {
    const unsigned u = __float_as_uint(s);
    const unsigned o = (u & 0x80000000u) ? ~u : (u | 0x80000000u);
    return (o & ~((1u << LB) - 1u)) | (((1u << LB) - 1u) - payload);
}
template <int LB> __device__ __forceinline__ float key_val(unsigned k) {
    const unsigned o = k & ~((1u << LB) - 1u);
    const unsigned u = (o & 0x80000000u) ? (o & 0x7fffffffu) : ~o;
    return __uint_as_float(u);
}
template <int LB> __device__ __forceinline__ unsigned key_payload(unsigned k) { return ((1u << LB) - 1u) - (k & ((1u << LB) - 1u)); }
#define CMPEX_D(a, b) do { const unsigned _x = (a), _y = (b); (a) = _x > _y ? _x : _y; (b) = _x > _y ? _y : _x; } while (0)
__device__ __forceinline__ void sort16_desc(unsigned (&a)[16]) {
#pragma unroll
    for (int k = 2; k <= 16; k <<= 1)
#pragma unroll
        for (int j = k >> 1; j > 0; j >>= 1)
#pragma unroll
            for (int i = 0; i < 16; ++i) {
                const int l = i ^ j;
                if (l > i) {
                    if ((i & k) == 0) CMPEX_D(a[i], a[l]);
                    else CMPEX_D(a[l], a[i]);
                }
            }
}
__device__ __forceinline__ void merge16_desc(unsigned (&run)[16], const unsigned (&b)[16]) {
#pragma unroll
    for (int i = 0; i < 16; ++i) run[i] = run[i] > b[15 - i] ? run[i] : b[15 - i];
#pragma unroll
    for (int j = 8; j > 0; j >>= 1)
#pragma unroll
        for (int i = 0; i < 16; ++i) {
            const int l = i ^ j;
            if (l > i) CMPEX_D(run[i], run[l]);
        }
}

__device__ __forceinline__ void route_list(const bf16_t* __restrict__ PQ, const bf16_t* __restrict__ KEYS, int t0, int hp, int r, int hh, unsigned (&run)[16]) {
    bf16x8 qf[8];
    {
        const bf16_t* qp = PQ + (size_t)(t0 + r) * 2048 + hp * 128 + hh * 8;
#pragma unroll
        for (int ks = 0; ks < 8; ++ks) qf[ks] = *(const bf16x8*)(qp + ks * 16);
    }
    const bf16_t* kp = KEYS + ((size_t)hp * 128 + r) * 128 + hh * 8;
#pragma unroll
    for (int e = 0; e < 16; ++e) run[e] = 0u;
    bf16x8 kf[8];
#pragma unroll
    for (int ks = 0; ks < 8; ++ks) kf[ks] = *(const bf16x8*)(kp + ks * 16);
#pragma unroll 1
    for (int mt = 0; mt < 4; ++mt) {
        f32x16 s = {};
#pragma unroll
        for (int ks = 0; ks < 8; ++ks) s = __builtin_amdgcn_mfma_f32_32x32x16_bf16(kf[ks], qf[ks], s, 0, 0, 0);
        {
            const bf16_t* kn = kp + (size_t)((mt + 1) & 3) * 32 * 128;
#pragma unroll
            for (int ks = 0; ks < 8; ++ks) kf[ks] = *(const bf16x8*)(kn + ks * 16);
        }
        unsigned cur[16];
#pragma unroll
        for (int e = 0; e < 16; ++e) {
            const unsigned n = (unsigned)(32 * mt + (e & 3) + 8 * (e >> 2) + 4 * hh);
            cur[e] = mk_key<7>(s[e], n);
        }
        sort16_desc(cur);
        merge16_desc(run, cur);
    }
    unsigned oth[16];
#pragma unroll
    for (int e = 0; e < 16; ++e) oth[e] = (unsigned)__shfl_xor((int)run[e], 32);
    merge16_desc(run, oth);
}

__device__ __forceinline__ void ph_route(const bf16_t* __restrict__ PQ, const bf16_t* __restrict__ KEYS, int* __restrict__ EIDX,
                                         float* __restrict__ GW, unsigned char* smem, const int g_wave) {
    const int lane = lane_id(), r = lane & 31, hh = lane >> 5, wid = g_wave;
    unsigned* ibuf = (unsigned*)(smem + wid * 2048);
    for (int task = blockIdx.x * 8 + wid; task < (NTOK / 32) * 4; task += gridDim.x * 8) {
        const int tg = task >> 2, hp2 = task & 3, t0 = tg * 32;
        unsigned L0[16], L1[16], L2[16], L3[16];
        route_list(PQ, KEYS, t0, hp2 * 4 + 0, r, hh, L0); __builtin_amdgcn_sched_barrier(0);
        route_list(PQ, KEYS, t0, hp2 * 4 + 1, r, hh, L1); __builtin_amdgcn_sched_barrier(0);
        route_list(PQ, KEYS, t0, hp2 * 4 + 2, r, hh, L2); __builtin_amdgcn_sched_barrier(0);
        route_list(PQ, KEYS, t0, hp2 * 4 + 3, r, hh, L3); __builtin_amdgcn_sched_barrier(0);
        unsigned A[16], B[16];
#pragma unroll
        for (int e = 0; e < 16; ++e) { A[e] = hh ? L2[e] : L0[e]; B[e] = hh ? L3[e] : L1[e]; }
#pragma unroll
        for (int j = 0; j < 4; ++j) {
            unsigned wa = 0, wb = 0;
#pragma unroll
            for (int q = 0; q < 4; ++q) { wa |= key_payload<7>(A[4 * j + q]) << (8 * q); wb |= key_payload<7>(B[4 * j + q]) << (8 * q); }
            ibuf[j * 64 + lane] = wa; ibuf[(4 + j) * 64 + lane] = wb;
        }
        float va[16], vb[16];
#pragma unroll
        for (int e = 0; e < 16; ++e) { va[e] = key_val<7>(A[e]); vb[e] = key_val<7>(B[e]); }
#define CAND(k, i, j) grp[k] = mk_key<8>(va[i] + vb[j], (unsigned)((i) * 16 + (j)))
        unsigned fin[16], grp[16];
        CAND(0, 0, 0); CAND(1, 0, 1); CAND(2, 0, 2); CAND(3, 0, 3); CAND(4, 0, 4); CAND(5, 0, 5); CAND(6, 0, 6); CAND(7, 0, 7); CAND(8, 0, 8); CAND(9, 0, 9); CAND(10, 0, 10); CAND(11, 0, 11); CAND(12, 0, 12); CAND(13, 0, 13); CAND(14, 0, 14); CAND(15, 0, 15);
        sort16_desc(grp);
#pragma unroll
        for (int e = 0; e < 16; ++e) fin[e] = grp[e];
        CAND(0, 1, 0); CAND(1, 1, 1); CAND(2, 1, 2); CAND(3, 1, 3); CAND(4, 1, 4); CAND(5, 1, 5); CAND(6, 1, 6); CAND(7, 1, 7); CAND(8, 2, 0); CAND(9, 2, 1); CAND(10, 2, 2); CAND(11, 2, 3); CAND(12, 2, 4); CAND(13, 3, 0); CAND(14, 3, 1); CAND(15, 3, 2);
        sort16_desc(grp);
        merge16_desc(fin, grp);
        CAND(0, 3, 3); CAND(1, 4, 0); CAND(2, 4, 1); CAND(3, 4, 2); CAND(4, 5, 0); CAND(5, 5, 1); CAND(6, 6, 0); CAND(7, 6, 1); CAND(8, 7, 0); CAND(9, 7, 1); CAND(10, 8, 0); CAND(11, 9, 0); CAND(12, 10, 0); CAND(13, 11, 0); CAND(14, 12, 0); CAND(15, 13, 0);
        sort16_desc(grp);
        merge16_desc(fin, grp);
        CAND(0, 14, 0); CAND(1, 15, 0);
        grp[2] = 0u; grp[3] = 0u; grp[4] = 0u; grp[5] = 0u; grp[6] = 0u; grp[7] = 0u; grp[8] = 0u; grp[9] = 0u; grp[10] = 0u; grp[11] = 0u; grp[12] = 0u; grp[13] = 0u; grp[14] = 0u; grp[15] = 0u;
        sort16_desc(grp);
        merge16_desc(fin, grp);
#undef CAND
        float fv[16], sum = 0.f;
        const float fmax0 = key_val<8>(fin[0]);
#pragma unroll
        for (int e = 0; e < 16; ++e) { fv[e] = __expf(key_val<8>(fin[e]) - fmax0); sum += fv[e]; }
        const float inv = 1.f / sum;
        const size_t ob = ((size_t)(t0 + r) * 8 + (hp2 * 2 + hh)) * 16;
#pragma unroll
        for (int q4 = 0; q4 < 4; ++q4) {
            int ev[4]; float gv[4];
#pragma unroll
            for (int q = 0; q < 4; ++q) {
                const int e = q4 * 4 + q;
                const unsigned c = key_payload<8>(fin[e]);
                const unsigned ci = c >> 4, cj = c & 15u;
                const unsigned wa = ibuf[(ci >> 2) * 64 + lane], wb = ibuf[(4 + (cj >> 2)) * 64 + lane];
                const unsigned i1 = (wa >> (8 * (ci & 3u))) & 0xffu, i2 = (wb >> (8 * (cj & 3u))) & 0xffu;
                ev[q] = (int)(i1 * 128u + i2);
                gv[q] = fv[e] * inv;
            }
            *(int4*)(EIDX + ob + q4 * 4) = make_int4(ev[0], ev[1], ev[2], ev[3]);
            *(f32x4*)(GW + ob + q4 * 4) = (f32x4){gv[0], gv[1], gv[2], gv[3]};
        }
    }
}

template <bool SIGNED> __device__ __forceinline__ void cvt_table_i8(const float* __restrict__ src, unsigned char* __restrict__ dst, float* __restrict__ scales, int nrows, const int g_wave) {
    const int lane = lane_id(), wid = g_wave;
    for (int row = blockIdx.x * 8 + wid; row < nrows; row += gridDim.x * 8) {
        const float* sp = src + (size_t)row * 1024 + lane * 16;
        f32x4 v[4];
        float mx = 0.f;
#pragma unroll
        for (int c = 0; c < 4; ++c) { v[c] = *(const f32x4*)(sp + c * 4); mx = fmaxf(mx, fmaxf(fmaxf(fabsf(v[c][0]), fabsf(v[c][1])), fmaxf(fabsf(v[c][2]), fabsf(v[c][3])))); }
#pragma unroll
        for (int o = 32; o > 0; o >>= 1) mx = fmaxf(mx, __shfl_xor(mx, o));
        const float sc = fmaxf(mx, 1e-30f) * (1.f / 127.f), inv = 1.f / sc;
        u32x4 w;
#pragma unroll
        for (int c = 0; c < 4; ++c) {
            unsigned pk = 0;
#pragma unroll
            for (int e = 0; e < 4; ++e) pk |= (SIGNED ? ((unsigned)(int)rintf(v[c][e] * inv) & 0xffu) : (unsigned)((int)rintf(v[c][e] * inv) + 128)) << (8 * e);
            w[c] = pk;
        }
        *(u32x4*)(dst + (size_t)row * 1024 + lane * 16) = w;
        if (lane == 0) scales[row] = sc;
    }
}

__device__ __forceinline__ float ub0(unsigned w) { return (float)(w & 0xffu); }
__device__ __forceinline__ float ub1(unsigned w) { return (float)((w >> 8) & 0xffu); }
__device__ __forceinline__ float ub2(unsigned w) { return (float)((w >> 16) & 0xffu); }
__device__ __forceinline__ float ub3(unsigned w) { return (float)(w >> 24); }

struct GTok { float sh, tsum; float acc[16]; };
__device__ __forceinline__ float gv6_dots8(const u32x4 (&u)[16], int j0, const u32x4 hq_lo, const u32x4 hq_hi, float my_su, float my_gv, float my_sh, int lane) {
    float pj[8];
#pragma unroll
    for (int j = 0; j < 8; ++j) {
        int s = 0;
#pragma unroll
        for (int c = 0; c < 4; ++c) s = __builtin_amdgcn_sdot4((int)u[j0 + j][c], (int)(j < 4 ? hq_lo[c] : hq_hi[c]), s, false);
        pj[j] = (float)s;
    }
    float q4[4], q2[2], q1;
#pragma unroll
    for (int m = 0; m < 4; ++m) {
        const auto rr = __builtin_amdgcn_permlane32_swap(__float_as_uint(pj[m]), __float_as_uint(pj[4 + m]), false, false);
        q4[m] = __uint_as_float(rr[0]) + __uint_as_float(rr[1]);
    }
#pragma unroll
    for (int m = 0; m < 2; ++m) {
        const auto rr = __builtin_amdgcn_permlane16_swap(__float_as_uint(q4[m]), __float_as_uint(q4[2 + m]), false, false);
        q2[m] = __uint_as_float(rr[0]) + __uint_as_float(rr[1]);
    }
    {
        const bool up = (lane & 8) != 0;
        const float keep = up ? q2[1] : q2[0], send = up ? q2[0] : q2[1];
        q1 = keep + __uint_as_float((unsigned)__builtin_amdgcn_update_dpp(0, (int)__float_as_uint(send), 0x128, 0xf, 0xf, false));
    }
    q1 += __uint_as_float((unsigned)__builtin_amdgcn_update_dpp(0, (int)__float_as_uint(q1), 0xB1, 0xf, 0xf, false));
    q1 += __uint_as_float((unsigned)__builtin_amdgcn_update_dpp(0, (int)__float_as_uint(q1), 0x4E, 0xf, 0xf, false));
    q1 += __uint_as_float((unsigned)__builtin_amdgcn_update_dpp(0, (int)__float_as_uint(q1), 0x141, 0xf, 0xf, false));
    const float d = my_su * my_sh * q1;
    return 0.5f * d * (1.f + erff(d * 0.70710678118654752f)) * my_gv;
}
__device__ __forceinline__ void gv6_dots_step(const unsigned char* __restrict__ U8, unsigned* lst0, int k, int ids, float sh01, float sh23, int lane) {
    u32x4 u[16];
#pragma unroll
    for (int j = 0; j < 16; ++j) {
        const int e = __builtin_amdgcn_readlane(ids, j);
        u[j] = *(const u32x4*)(U8 + (size_t)e * 1024 + lane * 16);
    }
    const int tl = lane >> 5, rk = 4 * k + ((lane >> 3) & 3);
    unsigned* la = lst0 + tl * 768; unsigned* lb = lst0 + (2 + tl) * 768;
    const float su_a = __uint_as_float(la[128 + rk]), gv_a = __uint_as_float(la[256 + rk]);
    const float su_b = __uint_as_float(lb[128 + rk]), gv_b = __uint_as_float(lb[256 + rk]);
    const u32x4 h0 = *(const u32x4*)(lst0 + 384 + lane * 4), h1 = *(const u32x4*)(lst0 + 768 + 384 + lane * 4);
    const u32x4 h2 = *(const u32x4*)(lst0 + 1536 + 384 + lane * 4), h3 = *(const u32x4*)(lst0 + 2304 + 384 + lane * 4);
    const float a_a = gv6_dots8(u, 0, h0, h1, su_a, gv_a, sh01, lane);
    const float a_b = gv6_dots8(u, 8, h2, h3, su_b, gv_b, sh23, lane);
    if ((lane & 7) == 0) { la[640 + rk] = __float_as_uint(a_a); lb[640 + rk] = __float_as_uint(a_b); }
}
__device__ __forceinline__ void gv6_accum_step(const unsigned char* __restrict__ V8, int ids, float av, GTok& T0, GTok& T1, GTok& T2, GTok& T3, int lane) {
    u32x4 v[16];
#pragma unroll
    for (int j = 0; j < 16; ++j) {
        const int e = __builtin_amdgcn_readlane(ids, j);
        v[j] = *(const u32x4*)(V8 + (size_t)e * 1024 + lane * 16);
    }
#define GV6_ACC(TK, j) do { const float aj = __builtin_bit_cast(float, __builtin_amdgcn_readlane(__builtin_bit_cast(int, av), (j))); (TK).tsum += aj; \
        _Pragma("unroll") for (int c = 0; c < 4; ++c) { const unsigned w = v[(j)][c]; \
            (TK).acc[4 * c] += aj * ub0(w); (TK).acc[4 * c + 1] += aj * ub1(w); (TK).acc[4 * c + 2] += aj * ub2(w); (TK).acc[4 * c + 3] += aj * ub3(w); } } while (0)
    GV6_ACC(T0, 0); GV6_ACC(T0, 1); GV6_ACC(T0, 2); GV6_ACC(T0, 3);
    GV6_ACC(T1, 4); GV6_ACC(T1, 5); GV6_ACC(T1, 6); GV6_ACC(T1, 7);
    GV6_ACC(T2, 8); GV6_ACC(T2, 9); GV6_ACC(T2, 10); GV6_ACC(T2, 11);
    GV6_ACC(T3, 12); GV6_ACC(T3, 13); GV6_ACC(T3, 14); GV6_ACC(T3, 15);
#undef GV6_ACC
}
__device__ __forceinline__ void gv3_sort128(unsigned& a, unsigned& b, int lane) {
#pragma unroll
    for (int k = 2; k <= 64; k <<= 1) {
        const bool asc_a = (k == 64) ? true : ((lane & k) == 0), asc_b = (k == 64) ? false : ((lane & k) == 0);
#pragma unroll
        for (int j = k >> 1; j >= 1; j >>= 1) {
            const unsigned pa = (unsigned)__shfl_xor((int)a, j), pb = (unsigned)__shfl_xor((int)b, j);
            const bool lower = (lane & j) == 0;
            a = (lower == asc_a) ? (a < pa ? a : pa) : (a > pa ? a : pa);
            b = (lower == asc_b) ? (b < pb ? b : pb) : (b > pb ? b : pb);
        }
    }
    { const unsigned lo = a < b ? a : b, hi = a < b ? b : a; a = lo; b = hi; }
#pragma unroll
    for (int j = 32; j >= 1; j >>= 1) {
        const unsigned pa = (unsigned)__shfl_xor((int)a, j), pb = (unsigned)__shfl_xor((int)b, j);
        const bool lower = (lane & j) == 0;
        a = lower ? (a < pa ? a : pa) : (a > pa ? a : pa);
        b = lower ? (b < pb ? b : pb) : (b > pb ? b : pb);
    }
}
__device__ __forceinline__ void gv3_load_token(GTok& T, unsigned* lst, int tok, const bf16_t* __restrict__ Hb, const int* __restrict__ EIDX, const float* __restrict__ GW,
                                               const float* __restrict__ SU, const float* __restrict__ SV, int lane) {
    float h[16];
    {
        const u32x4 a = *(const u32x4*)(Hb + (size_t)tok * 1024 + lane * 16), b = *(const u32x4*)(Hb + (size_t)tok * 1024 + lane * 16 + 8);
#pragma unroll
        for (int c = 0; c < 4; ++c) { h[2 * c] = bflo(a[c]); h[2 * c + 1] = bfhi(a[c]); h[8 + 2 * c] = bflo(b[c]); h[8 + 2 * c + 1] = bfhi(b[c]); }
    }
    float mx = 0.f;
#pragma unroll
    for (int i = 0; i < 16; ++i) mx = fmaxf(mx, fabsf(h[i]));
#pragma unroll
    for (int o = 32; o > 0; o >>= 1) mx = fmaxf(mx, __shfl_xor(mx, o));
    T.sh = fmaxf(mx, 1e-30f) * (1.f / 127.f);
    const float inv = 1.f / T.sh;
    u32x4 hq;
#pragma unroll
    for (int c = 0; c < 4; ++c) {
        unsigned pk = 0;
#pragma unroll
        for (int e = 0; e < 4; ++e) pk |= ((unsigned)(int)rintf(h[4 * c + e] * inv) & 0xffu) << (8 * e);
        hq[c] = pk;
    }
    *(u32x4*)(lst + 384 + lane * 4) = hq;
    {
        unsigned ka = ((unsigned)EIDX[(size_t)tok * 128 + lane] << 7) | (unsigned)lane, kb = ((unsigned)EIDX[(size_t)tok * 128 + 64 + lane] << 7) | (unsigned)(64 + lane);
        gv3_sort128(ka, kb, lane);
        const int e_lo = (int)(ka >> 7), e_hi = (int)(kb >> 7);
        const float* gwt = GW + (size_t)tok * 128;
        lst[lane] = (unsigned)e_lo; lst[64 + lane] = (unsigned)e_hi;
        lst[128 + lane] = __float_as_uint(SU[e_lo]); lst[192 + lane] = __float_as_uint(SU[e_hi]);
        lst[256 + lane] = __float_as_uint(gwt[ka & 127u] * SV[e_lo]); lst[320 + lane] = __float_as_uint(gwt[kb & 127u] * SV[e_hi]);
    }
    T.tsum = 0.f;
#pragma unroll
    for (int i = 0; i < 16; ++i) T.acc[i] = 0.f;
}
__device__ __forceinline__ void gv3_store_token(const float (&acc)[16], int tok, const bf16_t* X, bf16_t* Xo, const float* __restrict__ gate, const float* __restrict__ ng,
                                                const float* __restrict__ nmod, bf16_t* Hn, float* fout, unsigned char* Hn8) {
    const int lane = lane_id();
    const bf16_t* xp = X + (size_t)tok * 1024 + lane * 16;
    const float* gp = gate + (size_t)(tok >> 12) * 6144 + lane * 16;
    f32x4 xn[4];
    float ss = 0.f;
    {
        const u32x4 xa = *(const u32x4*)xp, xb = *(const u32x4*)(xp + 8);
        const unsigned xw[8] = {xa.x, xa.y, xa.z, xa.w, xb.x, xb.y, xb.z, xb.w};
#pragma unroll
        for (int c = 0; c < 4; ++c) {
            const f32x4 gv = *(const f32x4*)(gp + c * 4);
            const float xv[4] = {bflo(xw[2 * c]), bfhi(xw[2 * c]), bflo(xw[2 * c + 1]), bfhi(xw[2 * c + 1])};
#pragma unroll
            for (int e = 0; e < 4; ++e) { xn[c][e] = xv[e] + gv[e] * acc[4 * c + e]; ss += xn[c][e] * xn[c][e]; }
        }
    }
    if (ng == nullptr || fout == nullptr) {
        bf16_t* xo = Xo + (size_t)tok * 1024 + lane * 16;
        *(u32x4*)xo = (u32x4){cvt_pk_bf16(xn[0][0], xn[0][1]), cvt_pk_bf16(xn[0][2], xn[0][3]), cvt_pk_bf16(xn[1][0], xn[1][1]), cvt_pk_bf16(xn[1][2], xn[1][3])};
        *(u32x4*)(xo + 8) = (u32x4){cvt_pk_bf16(xn[2][0], xn[2][1]), cvt_pk_bf16(xn[2][2], xn[2][3]), cvt_pk_bf16(xn[3][0], xn[3][1]), cvt_pk_bf16(xn[3][2], xn[3][3])};
    }
    if (ng != nullptr) {
        ss = warp_sum(ss);
        const float rs = rsqrtf(ss * (1.f / 1024.f) + 1e-6f);
        if (fout != nullptr) {
#pragma unroll
            for (int c = 0; c < 4; ++c) {
                const f32x4 gg = *(const f32x4*)(ng + lane * 16 + c * 4);
                *(f32x4*)(fout + (size_t)tok * 1024 + lane * 16 + c * 4) = xn[c] * rs * gg;
            }
        } else {
            const float* shp = nmod + (size_t)(tok >> 12) * 6144 + lane * 16;
            unsigned w[8]; u32x4 w8;
#pragma unroll
            for (int c = 0; c < 4; ++c) {
                const f32x4 gg = *(const f32x4*)(ng + lane * 16 + c * 4), sh = *(const f32x4*)(shp + c * 4), sc = *(const f32x4*)(shp + 1024 + c * 4);
                float y[4];
#pragma unroll
                for (int e = 0; e < 4; ++e) y[e] = xn[c][e] * rs * gg[e] * (1.f + sc[e]) + sh[e];
                w[2 * c] = cvt_pk_bf16(y[0], y[1]); w[2 * c + 1] = cvt_pk_bf16(y[2], y[3]);
                int pk = __builtin_amdgcn_cvt_pk_fp8_f32(y[0], y[1], 0, false);
                pk = __builtin_amdgcn_cvt_pk_fp8_f32(y[2], y[3], pk, true);
                w8[c] = (unsigned)pk;
            }
            if (Hn8 != nullptr) *(u32x4*)(Hn8 + (size_t)tok * 1024 + lane * 16) = w8;
            *(u32x4*)(Hn + (size_t)tok * 1024 + lane * 16) = (u32x4){w[0], w[1], w[2], w[3]};
            *(u32x4*)(Hn + (size_t)tok * 1024 + lane * 16 + 8) = (u32x4){w[4], w[5], w[6], w[7]};
        }
    }
}
__device__ __forceinline__ void ph_gather9(const bf16_t* __restrict__ Hb, const unsigned char* __restrict__ U8, const unsigned char* __restrict__ V8,
                                           const float* __restrict__ SU, const float* __restrict__ SV, const int* __restrict__ EIDX,
                                           const float* __restrict__ GW, const bf16_t* X, bf16_t* Xo, const float* __restrict__ gate,
                                           const float* __restrict__ ng, const float* __restrict__ nmod, bf16_t* Hn, float* fout, unsigned char* smem, const int g_wave, unsigned char* Hn8) {
    const int lane = lane_id(), wid = g_wave;
    const int wg = blockIdx.x * 8 + wid, NW = gridDim.x * 8;
    f32x4* accl = (f32x4*)(smem + wid * 16384) + lane;
    unsigned* lst0 = (unsigned*)(smem + wid * 16384);
    for (int base = wg * 4; base < NTOK; base += NW * 4) {
        GTok T0, T1, T2, T3;
        gv3_load_token(T0, lst0, base + 0, Hb, EIDX, GW, SU, SV, lane); gv3_load_token(T1, lst0 + 768, base + 1, Hb, EIDX, GW, SU, SV, lane);
        gv3_load_token(T2, lst0 + 1536, base + 2, Hb, EIDX, GW, SU, SV, lane); gv3_load_token(T3, lst0 + 2304, base + 3, Hb, EIDX, GW, SU, SV, lane);
        {
            const unsigned* idp = lst0 + ((lane >> 2) & 3) * 768 + (lane & 3);
            const float sh01 = (lane < 32) ? T0.sh : T1.sh, sh23 = (lane < 32) ? T2.sh : T3.sh;
            int ids = (int)idp[0];
#pragma unroll 1
            for (int k = 0; k < 32; ++k) {
                const int cur = ids;
                ids = (int)idp[(4 * (k + 1)) & 127];
                gv6_dots_step(U8, lst0, k, cur, sh01, sh23, lane);
                if ((k & 15) == 15) __syncthreads();
            }
            ids = (int)idp[0];
            float av = __uint_as_float(idp[640]);
#pragma unroll 1
            for (int k = 0; k < 32; ++k) {
                const int cur = ids; const float cav = av;
                ids = (int)idp[(4 * (k + 1)) & 127]; av = __uint_as_float(idp[640 + ((4 * (k + 1)) & 127)]);
                gv6_accum_step(V8, cur, cav, T0, T1, T2, T3, lane);
                if ((k & 15) == 15) __syncthreads();
            }
        }
        asm volatile("" ::: "memory");
#define GV3_PARK(TK, tk) do { const float t128 = 128.f * (TK).tsum;        \
            _Pragma("unroll") for (int c = 0; c < 4; ++c) accl[((tk) * 4 + c) * 64] = (f32x4){(TK).acc[4 * c] - t128, (TK).acc[4 * c + 1] - t128, (TK).acc[4 * c + 2] - t128, (TK).acc[4 * c + 3] - t128}; } while (0)
        GV3_PARK(T0, 0); GV3_PARK(T1, 1); GV3_PARK(T2, 2); GV3_PARK(T3, 3);
#undef GV3_PARK
#pragma unroll 1
        for (int tk = 0; tk < 4; ++tk) {
            float acc[16];
#pragma unroll
            for (int c = 0; c < 4; ++c) { const f32x4 t4 = accl[(tk * 4 + c) * 64]; acc[4 * c] = t4[0]; acc[4 * c + 1] = t4[1]; acc[4 * c + 2] = t4[2]; acc[4 * c + 3] = t4[3]; }
            gv3_store_token(acc, base + tk, X, Xo, gate, ng, nmod, Hn, fout, Hn8);
        }
        asm volatile("" ::: "memory");
    }
}

__device__ __forceinline__ void ph_filt_mlp(const MP& p, unsigned char* smem, const int g_wave) {
    const int lane = lane_id(), wid = g_wave, tid = (wid << 6) | lane;
    float* wl = (float*)smem;
    float* buf = (float*)(smem + 49152) + wid * 128;
    const float* w1 = p.in[18]; const float* b1 = p.in[19]; const float* w2 = p.in[20]; const float* b2 = p.in[21];
    const float* w3 = p.in[22]; const float* b3 = p.in[23]; const float* fq = p.in[25];
    float* a3 = (float*)(p.ws + WS_A3);
    __syncthreads();
    for (int e = tid; e < 33 * 64; e += 512) wl[e] = w1[e];
    for (int e = tid; e < 64 * 64; e += 512) { wl[2112 + e] = w2[e]; wl[6208 + e] = w3[e]; }
    __syncthreads();
    const float fr = fq[lane], bb1 = b1[lane], bb2 = b2[lane], bb3 = b3[lane];
    for (int pos = blockIdx.x * 8 + wid; pos < FILT_L; pos += gridDim.x * 8) {
        const float L = (float)FILT_L;
        float zv = 0.f;
        if (lane < 33) {
            const float t = (float)pos / (L - 1.f);
            const float w = (2.0f * 3.14159265358979323846f / L) * (float)pos;
            if (lane == 0) zv = t;
            else {
                const int bnd = (lane - 1) & 15;
                const float f = 1e-4f + (float)bnd * ((15.f - 1e-4f) / 15.f);
                zv = (lane <= 16) ? cosf(f * w) : -sinf(f * w);
            }
        }
        buf[lane] = zv;
        float acc = bb1;
#pragma unroll 3
        for (int k = 0; k < 33; ++k) acc += buf[k] * wl[k * 64 + lane];
        buf[64 + lane] = sinf(fr * acc);
        acc = bb2;
#pragma unroll 8
        for (int k = 0; k < 64; ++k) acc += buf[64 + k] * wl[2112 + k * 64 + lane];
        buf[lane] = sinf(fr * acc);
        acc = bb3;
#pragma unroll 8
        for (int k = 0; k < 64; ++k) acc += buf[k] * wl[6208 + k * 64 + lane];
        a3[(size_t)pos * 64 + lane] = sinf(fr * acc);
    }
}

__device__ __forceinline__ void ph_filt_table(const MP& p, unsigned char* smem, const int g_wave) {
    const int lane = lane_id(), wid = g_wave, tid = (wid << 6) | lane;
    float* a3s = (float*)smem;
    float* w4s = (float*)(smem + 64 * 65 * 4);
    const float* a3 = (const float*)(p.ws + WS_A3);
    const float* w4 = p.in[24]; const float* deltas = p.in[26];
    bf16_t* FILT = (bf16_t*)(p.ws + WS_FILT);
    float* FNORM = (float*)(p.ws + WS_FNORM);
    for (int u = blockIdx.x; u < 64 * 64; u += gridDim.x) {
        const int pos0 = (u & 63) * 64, col0 = (u >> 6) * 64;
        __syncthreads();
#pragma unroll
        for (int i = 0; i < 8; ++i) {
            const int rr = (tid >> 6) + 8 * i, cc = tid & 63;
            a3s[rr * 65 + cc] = a3[(size_t)(pos0 + rr) * 64 + cc];
            w4s[rr * 64 + cc] = w4[(size_t)rr * 4096 + col0 + cc];
        }
        __syncthreads();
        float acc[8];
#pragma unroll
        for (int cc = 0; cc < 8; ++cc) acc[cc] = 0.f;
#pragma unroll 2
        for (int k = 0; k < 64; ++k) {
            const float av = a3s[lane * 65 + k];
            const f32x4 wa = *(const f32x4*)(w4s + k * 64 + wid * 8), wb = *(const f32x4*)(w4s + k * 64 + wid * 8 + 4);
#pragma unroll
            for (int e = 0; e < 4; ++e) { acc[e] += av * wa[e]; acc[4 + e] += av * wb[e]; }
        }
        const int pos = pos0 + lane;
        const float t = (float)pos / 4095.f;
#pragma unroll
        for (int cc = 0; cc < 8; ++cc) {
            const int col = col0 + wid * 8 + cc;
            const int n = col >> 11, dir = (col >> 10) & 1, c = col & 1023;
            const float v = acc[cc] * __expf(-t * fabsf(deltas[n * 1024 + c]));
            const bool use = (dir == 0) || (pos > 0);
            if (use) FILT[((size_t)(n * 1024 + c)) * 8192 + (dir == 0 ? 4096 - pos : 4096 + pos)] = f2bf(v);
            const float s = warp_sum(use ? fabsf(v) : 0.f);
            if (lane == 0) atomicAdd(FNORM + n * 1024 + c, s);
        }
    }
}

constexpr int CV_RS = 5064, CV_PADL = 480;
constexpr int CV_UBYTES = 8 * CV_RS * 2;
constexpr int CV_FE = CV_UBYTES, CV_FO = CV_FE + 16384 + 64;
__device__ __forceinline__ float sconv_at(const bf16_t* __restrict__ row, int t, float w0, float w1, float w2, float cbv) {
    float a = cbv + w1 * bf2f(row[t]);
    if (t > 0) a += w0 * bf2f(row[t - 1]);
    if (t < SEQ - 1) a += w2 * bf2f(row[t + 1]);
    return a;
}
__device__ __forceinline__ void sconv4(const bf16_t* __restrict__ row, int t, float w0, float w1, float w2, float cbv, float (&o)[4]) {
    const u32x2 w = *(const u32x2*)(row + t);
    const float x0 = bflo(w.x), x1 = bfhi(w.x), x2 = bflo(w.y), x3 = bfhi(w.y);
    const float xm = (t > 0) ? bf2f(row[t - 1]) : 0.f, xp = (t + 4 < SEQ) ? bf2f(row[t + 4]) : 0.f;
    o[0] = cbv + w0 * xm + w1 * x0 + w2 * x1;
    o[1] = cbv + w0 * x0 + w1 * x1 + w2 * x2;
    o[2] = cbv + w0 * x1 + w1 * x2 + w2 * x3;
    o[3] = cbv + w0 * x2 + w1 * x3 + w2 * xp;
}
__device__ __forceinline__ void conv_load_filter(const bf16_t* __restrict__ F, unsigned char* smem, int tid) {
    const u32x4* src = (const u32x4*)F;
#pragma unroll
    for (int i = 0; i < 2; ++i) *(u32x4*)(smem + CV_FE + (tid + 512 * i) * 16) = src[tid + 512 * i];
    const unsigned* sd = (const unsigned*)F;
#pragma unroll
    for (int i = 0; i < 8; ++i) {
        const int y = tid + 512 * i;
        const unsigned lo = sd[y], hi = (y < 4095) ? sd[y + 1] : 0u;
        *(unsigned*)(smem + CV_FO + y * 4) = (lo >> 16) | (hi << 16);
    }
}
__device__ __forceinline__ u32x4 cv_taps(const unsigned char* fp) { u32x4 a; a.x = *(const unsigned*)(fp); a.y = *(const unsigned*)(fp + 4); a.z = *(const unsigned*)(fp + 8); a.w = *(const unsigned*)(fp + 12); return a; }
template <int MODE>
__device__ __forceinline__ void conv_block(const unsigned char* fp, const unsigned char* up, bf16x8 (&R)[26], u32x4& A0, u32x4& A1, f32x16 (&acc)[4]) {
#pragma unroll
    for (int j = 0; j < 26; ++j) {
        if (MODE != 2 || j < 25) {
            R[(j + 1) % 26] = *(const bf16x8*)(up - 32 * (j + 1));
            if (j & 1) A0 = cv_taps(fp - 32 * (j + 1)); else A1 = cv_taps(fp - 32 * (j + 1));
        }
        const bf16x8 af = __builtin_bit_cast(bf16x8, (j & 1) ? A1 : A0);
        if (MODE != 2 || j <= 1) acc[0] = __builtin_amdgcn_mfma_f32_32x32x16_bf16(af, R[j], acc[0], 0, 0, 0);
        if ((MODE != 0 || j >= 8) && (MODE != 2 || j <= 9)) acc[1] = __builtin_amdgcn_mfma_f32_32x32x16_bf16(af, R[(j + 18) % 26], acc[1], 0, 0, 0);
        if ((MODE != 0 || j >= 16) && (MODE != 2 || j <= 17)) acc[2] = __builtin_amdgcn_mfma_f32_32x32x16_bf16(af, R[(j + 10) % 26], acc[2], 0, 0, 0);
        if (MODE != 0 || j >= 24) acc[3] = __builtin_amdgcn_mfma_f32_32x32x16_bf16(af, R[(j + 2) % 26], acc[3], 0, 0, 0);
    }
}
__device__ __forceinline__ void conv_main(const unsigned char* smem, int wid, int lane, f32x16 (&acc)[4]) {
    const int i = lane & 31, hh = lane >> 5, n = lane & 31, b = n >> 2, q = n & 3;
    const int T0w = 512 * wid, d0 = T0w - 4080;
#pragma unroll
    for (int a = 0; a < 4; ++a) acc[a] = (f32x16){};
    const unsigned char* fp = smem + ((i & 1) ? CV_FO : CV_FE) + ((4096 - i + 8 * hh) >> 1) * 4 - d0 * 2;
    const unsigned char* up = smem + (b * CV_RS + CV_PADL + 32 * q + 8 * hh + (T0w - d0)) * 2;
    bf16x8 R[26];
    u32x4 A0, A1;
    R[0] = *(const bf16x8*)up;
    A0 = cv_taps(fp);
    conv_block<0>(fp, up, R, A0, A1, acc);
    fp -= 32 * 26; up -= 32 * 26;
#pragma unroll 1
    for (int outer = 1; outer < 10; ++outer) {
        conv_block<1>(fp, up, R, A0, A1, acc);
        fp -= 32 * 26; up -= 32 * 26;
    }
    conv_block<2>(fp, up, R, A0, A1, acc);
}
__device__ __forceinline__ void ph_conv(const MP& p, const bf16_t* __restrict__ pT, bf16_t* __restrict__ z2T, unsigned char* smem, const int g_wave) {
    const int wid = g_wave;
    const float* cw = p.in[16]; const float* cb = p.in[17]; const float* hbias = p.in[27];
    const bf16_t* FILT = (const bf16_t*)(p.ws + WS_FILT);
    const float* FNORM = (const float*)(p.ws + WS_FNORM);
    const float* prs = (const float*)(p.ws + WS_WIN8S);
    for (int c = blockIdx.x; c < 1024; c += gridDim.x) {
        __syncthreads();
        {
            const int tid = (wid << 6) | lane_id();
            const float ps = prs[c], w0 = cw[c] * ps, w1 = cw[3072 + c] * ps, w2 = cw[6144 + c] * ps, cbv = cb[c];
            for (int ch = tid; ch < 8 * 512; ch += 512) {
                const int b_ = ch >> 9, s8 = (ch & 511) * 8;
                const bf16_t* row = pT + (size_t)c * NTOK + (size_t)b_ * SEQ;
                float o0[4], o1[4];
                sconv4(row, s8, w0, w1, w2, cbv, o0);
                sconv4(row, s8 + 4, w0, w1, w2, cbv, o1);
                u32x4 w; w.x = cvt_pk_bf16(o0[0], o0[1]); w.y = cvt_pk_bf16(o0[2], o0[3]); w.z = cvt_pk_bf16(o1[0], o1[1]); w.w = cvt_pk_bf16(o1[2], o1[3]);
                *(u32x4*)(smem + (b_ * CV_RS + CV_PADL + s8) * 2) = w;
            }
            for (int e = tid; e < 8 * 484; e += 512) {
                const int b_ = e / 484, k = e % 484;
                const int off = (k < 240) ? k * 2 : (CV_PADL + SEQ + (k - 240) * 2);
                *(unsigned*)(smem + (b_ * CV_RS + off) * 2) = 0u;
            }
            conv_load_filter(FILT + (size_t)c * 8192, smem, tid);
        }
        __syncthreads();
        f32x16 acc[4];
        conv_main(smem, wid, lane_id(), acc);
        __syncthreads();
        {
            const int lane = lane_id(), tid = (wid << 6) | lane, hh = lane >> 5, n = lane & 31, b = n >> 2, q = n & 3;
            const int ch1 = 1024 + c;
            const float ps = prs[ch1], w0 = cw[ch1] * ps, w1 = cw[3072 + ch1] * ps, w2 = cw[6144 + ch1] * ps, cbv = cb[ch1];
            const float inv = 1.f / FNORM[c], bs = hbias[c];
            const bf16_t* row = pT + (size_t)ch1 * NTOK + (size_t)b * SEQ;
#pragma unroll
            for (int a = 0; a < 4; ++a)
#pragma unroll
                for (int g4 = 0; g4 < 4; ++g4) {
                    const int t = 512 * wid + 128 * a + 32 * q + 8 * g4 + 4 * hh;
                    unsigned char* up = smem + (b * CV_RS + CV_PADL + t) * 2;
                    const u32x2 vw = *(const u32x2*)up;
                    const float vv[4] = {bflo(vw.x), bfhi(vw.x), bflo(vw.y), bfhi(vw.y)};
                    float xs[4], z[4];
                    sconv4(row, t, w0, w1, w2, cbv, xs);
#pragma unroll
                    for (int e = 0; e < 4; ++e) z[e] = xs[e] * (acc[a][4 * g4 + e] * inv + bs * vv[e]);
                    u32x2 zw; zw.x = cvt_pk_bf16(z[0], z[1]); zw.y = cvt_pk_bf16(z[2], z[3]);
                    *(u32x2*)up = zw;
                }
            conv_load_filter(FILT + (size_t)(1024 + c) * 8192, smem, tid);
        }
        __syncthreads();
        conv_main(smem, wid, lane_id(), acc);
        {
            const int lane = lane_id(), hh = lane >> 5, n = lane & 31, b = n >> 2, q = n & 3;
            const int ch2 = 2048 + c;
            const float ps = prs[ch2], w0 = cw[ch2] * ps, w1 = cw[3072 + ch2] * ps, w2 = cw[6144 + ch2] * ps, cbv = cb[ch2];
            const float inv = 1.f / FNORM[1024 + c], bs = hbias[1024 + c];
            const bf16_t* row = pT + (size_t)ch2 * NTOK + (size_t)b * SEQ;
            bf16_t* orow = z2T + (size_t)c * NTOK + (size_t)b * SEQ;
#pragma unroll
            for (int a = 0; a < 4; ++a)
#pragma unroll
                for (int g4 = 0; g4 < 4; ++g4) {
                    const int t = 512 * wid + 128 * a + 32 * q + 8 * g4 + 4 * hh;
                    const u32x2 vw = *(const u32x2*)(smem + (b * CV_RS + CV_PADL + t) * 2);
                    const float vv[4] = {bflo(vw.x), bfhi(vw.x), bflo(vw.y), bfhi(vw.y)};
                    float xs[4], z[4];
                    sconv4(row, t, w0, w1, w2, cbv, xs);
#pragma unroll
                    for (int e = 0; e < 4; ++e) z[e] = xs[e] * (acc[a][4 * g4 + e] * inv + bs * vv[e]);
                    u32x2 zw; zw.x = cvt_pk_bf16(z[0], z[1]); zw.y = cvt_pk_bf16(z[2], z[3]);
                    *(u32x2*)(orow + t) = zw;
                }
        }
    }
}

__device__ __forceinline__ void ph_transpose(const bf16_t* __restrict__ src, bf16_t* __restrict__ dst, unsigned char* smem, const int g_wave) {
    const int tid = MYTID;
    bf16_t* tile = (bf16_t*)smem;
    const int rr = tid >> 3, cc = (tid & 7) * 8;
    for (int u = blockIdx.x; u < (1024 / 64) * (NTOK / 64); u += gridDim.x) {
        const int c0 = (u & 15) * 64, t0 = (u >> 4) * 64;
        const u32x4 w = *(const u32x4*)(src + (size_t)(c0 + rr) * NTOK + t0 + cc);
        __syncthreads();
#pragma unroll
        for (int e = 0; e < 4; ++e) *(unsigned*)(tile + rr * 66 + cc + 2 * e) = w[e];
        __syncthreads();
        unsigned short v[8];
#pragma unroll
        for (int e = 0; e < 8; ++e) v[e] = tile[(cc + e) * 66 + rr];
        u32x4 o;
        o.x = (unsigned)v[0] | ((unsigned)v[1] << 16); o.y = (unsigned)v[2] | ((unsigned)v[3] << 16);
        o.z = (unsigned)v[4] | ((unsigned)v[5] << 16); o.w = (unsigned)v[6] | ((unsigned)v[7] << 16);
        *(u32x4*)(dst + (size_t)(t0 + rr) * 1024 + c0 + cc) = o;
    }
}

#define XB_TMO      128
#define XB_XCNT(j)  (256  + 64 * (j))
#define XB_XSUB(j)  (1280 + 64 * (j))
#define XB_XGEN(j)  (2304 + 64 * (j))
#define XB_TOP      3328
#define XB_TOPGEN   3392
#define XCD_BAR_WORDS 3456
#define XB_SPIN_CAP (1u << 22)
__device__ __forceinline__ unsigned xb_ld(unsigned* p)              { return __hip_atomic_load(p, __ATOMIC_RELAXED, __HIP_MEMORY_SCOPE_AGENT); }
__device__ __forceinline__ unsigned xb_add(unsigned* p, unsigned v) { return __hip_atomic_fetch_add(p, v, __ATOMIC_RELAXED, __HIP_MEMORY_SCOPE_AGENT); }
__device__ __forceinline__ unsigned xb_xcc_id() { return (unsigned)__builtin_amdgcn_s_getreg((3 << 11) | 20) & 0xFu; }
#define XB_SPIN(cond, bar) do { unsigned _sp = 0; while (cond) { __builtin_amdgcn_s_sleep(1); \
    if ((++_sp & 255u) == 0u) { if (xb_ld(&(bar)[XB_TMO])) break; if (_sp > XB_SPIN_CAP) { atomicAdd(&(bar)[XB_TMO], 1u); break; } } } } while (0)
struct XcdBarrier { unsigned* bar; unsigned x; volatile LAS unsigned* st; };
__device__ __forceinline__ XcdBarrier xcd_barrier_post(unsigned* bar, volatile LAS unsigned* st, int tid) {
    XcdBarrier b; b.bar = bar; b.x = xb_xcc_id(); b.st = st;
    if (tid == 0) (void)xb_add(&bar[XB_XCNT(b.x)], 1u);
    return b;
}
__device__ __forceinline__ void xcd_barrier_complete(unsigned* bar, unsigned x, unsigned& nloc, unsigned& nx) {
    const unsigned G = gridDim.x;
    unsigned sum, cnt, mine, sp = 0u;
    for (;;) {
        sum = 0u; cnt = 0u; mine = 0u;
#pragma unroll
        for (unsigned j = 0; j < 16; ++j) { const unsigned c = xb_ld(&bar[XB_XCNT(j)]); sum += c; cnt += (c > 0u) ? 1u : 0u; mine = (j == x) ? c : mine; }
        if (sum == G) break;
        __builtin_amdgcn_s_sleep(1);
        if ((++sp & 255u) == 0u) { if (xb_ld(&bar[XB_TMO])) break; if (sp > XB_SPIN_CAP) { atomicAdd(&bar[XB_TMO], 1u); break; } }
    }
    nloc = mine > 0u ? mine : 1u; nx = cnt > 0u ? cnt : 1u;
}
__device__ __forceinline__ void xcd_barrier(const XcdBarrier& b, int tid) {
    asm volatile("s_waitcnt vmcnt(0)" ::: "memory");
    __syncthreads();
    if (tid == 0) {
        unsigned* bar = b.bar;
        __builtin_amdgcn_s_waitcnt(0);
        unsigned nloc = b.st[0], nx = b.st[1];
        if (nloc == 0u) { xcd_barrier_complete(bar, b.x, nloc, nx); b.st[0] = nloc; b.st[1] = nx; }
        const unsigned old = xb_add(&bar[XB_XSUB(b.x)], 1u);
        const unsigned gen = old / nloc;
        if (old + 1u == (gen + 1u) * nloc) {
            __builtin_amdgcn_fence(__ATOMIC_RELEASE, "agent");
            asm volatile("s_waitcnt vmcnt(0)" ::: "memory");
            const unsigned og = xb_add(&bar[XB_TOP], 1u);
            const unsigned tg = og / nx;
            if (og + 1u == (tg + 1u) * nx) xb_add(&bar[XB_TOPGEN], 1u);
            else XB_SPIN(xb_ld(&bar[XB_TOPGEN]) == tg, bar);
            __builtin_amdgcn_fence(__ATOMIC_ACQUIRE, "agent");
            xb_add(&bar[XB_XGEN(b.x)], 1u);
            asm volatile("s_waitcnt vmcnt(0)" ::: "memory");
        } else {
            XB_SPIN(xb_ld(&bar[XB_XGEN(b.x)]) == gen, bar);
            __builtin_amdgcn_fence(__ATOMIC_ACQUIRE, "agent");
            asm volatile("s_waitcnt vmcnt(0)" ::: "memory");
        }
    }
    __syncthreads();
}

#define RUN(k) (p.ph_lo <= (k) && (k) < p.ph_hi)
#define SYNC(k) do { if (p.ph_lo <= (k) && (k) + 1 < p.ph_hi) { if ((k) == 0) cg::this_grid().sync(); else xcd_barrier(xb, MYTID); } } while (0)
__global__ void __launch_bounds__(512, 2) mega(MP p) {
    __shared__ __attribute__((aligned(16))) unsigned char smem[STAGE_BYTES + 16];
    const int g_wave = __builtin_amdgcn_readfirstlane((int)(threadIdx.x >> 6));
    unsigned char* ws = p.ws;
    unsigned char* os = (unsigned char*)p.out;
    const int G = gridDim.x, bid = blockIdx.x;
    const float* modv = (const float*)(ws + WS_MODV);
    const float* rope = (const float*)(ws + WS_ROPE);
    float* RQ = (float*)(ws + WS_RQ);
    float* RK = (float*)(ws + WS_RK);
    bf16_t* Hb = (bf16_t*)(ws + WS_T0);
    bf16_t* Qb = (bf16_t*)(ws + WS_T0);
    bf16_t* Kb = (bf16_t*)(ws + WS_KB);
    bf16_t* VT = (bf16_t*)(ws + WS_VT);
    bf16_t* KRb = (bf16_t*)(ws + WS_KR);
    bf16_t* LATb = (bf16_t*)(os + OUT_LAT);
    bf16_t* Ob = (bf16_t*)(os + OUT_OB);
    bf16_t* X = (bf16_t*)(ws + WS_X);
    LAS unsigned char* lds = (LAS unsigned char*)smem;
    volatile LAS unsigned* xst = (volatile LAS unsigned*)(lds + STAGE_BYTES);
    if (MYTID == 0) { xst[0] = 0u; xst[1] = 0u; }
    __syncthreads();
    const XcdBarrier xb = xcd_barrier_post((unsigned*)(ws + WS_CTL), xst, MYTID);
    bf16_t* Hb2 = (bf16_t*)(ws + WS_T0);
    bf16_t* PQ = (bf16_t*)(ws + WS_T0 + 64 * MiB);
    int* EIDX = (int*)(ws + WS_T0 + 192 * MiB);
    float* GW = (float*)(ws + WS_T0 + 208 * MiB);
    const unsigned char* U8 = ws + WS_PT;
    const unsigned char* V8 = U8 + 16 * MiB;
    const float* PSC = (const float*)(ws + WS_PSC);
    const float* modv1 = modv + 9 * 6144;
    bf16_t* pT = (bf16_t*)(ws + WS_T0 + 64 * MiB);
    bf16_t* z2T = (bf16_t*)(ws + WS_T0);
    bf16_t* z2 = (bf16_t*)(ws + WS_T0 + 64 * MiB);
    if (((DUPSET >> 0) & 1) && RUN(0)) { constexpr bool dup = true; (void)dup; ph_prep(p, smem, g_wave); xcd_barrier(xb, MYTID); }
    if (RUN(0)) { constexpr bool dup = false; (void)dup; ph_prep(p, smem, g_wave); }
    SYNC(0);
    if (((DUPSET >> 1) & 1) && RUN(1)) { constexpr bool dup = true; (void)dup; ph_normmod<0>(p.in[0], p.in[2], p.in[6], modv, 0, Hb, g_wave); if (!dup) ph_filt_table(p, smem, g_wave); xcd_barrier(xb, MYTID); }
    if (RUN(1)) { constexpr bool dup = false; (void)dup; ph_normmod<0>(p.in[0], p.in[2], p.in[6], modv, 0, Hb, g_wave); if (!dup) ph_filt_table(p, smem, g_wave); ph_win8((const bf16_t*)(ws + WS_WIN), ws + WS_WIN8, (float*)(ws + WS_WIN8S), g_wave); }
    SYNC(1);
    if (((DUPSET >> 2) & 1) && RUN(2)) { constexpr bool dup = true; (void)dup; {
            Gemm g{Hb, (const bf16_t*)(ws + WS_WDKV), 1024, 1024, 1024};
            TileOrder S; S.init(NROW / 256, 3, G, bid, 0);
            EpiStoreBf16 E{LATb, 768};
            gemm_phase(lds, g, S, E, g_wave);
        } xcd_barrier(xb, MYTID); }
    if (RUN(2)) { constexpr bool dup = false; (void)dup; {
            Gemm g{Hb, (const bf16_t*)(ws + WS_WDKV), 1024, 1024, 1024};
            TileOrder S; S.init(NROW / 256, 3, G, bid, 0);
            EpiStoreBf16 E{LATb, 768};
            gemm_phase(lds, g, S, E, g_wave);
        } }
    SYNC(2);
    if (((DUPSET >> 3) & 1) && RUN(3)) { constexpr bool dup = true; (void)dup; ph_latpost(LATb, rope, RQ, RK, KRb, g_wave); xcd_barrier(xb, MYTID); }
    if (RUN(3)) { constexpr bool dup = false; (void)dup; ph_latpost(LATb, rope, RQ, RK, KRb, g_wave); }
    SYNC(3);
    if (((DUPSET >> 4) & 1) && RUN(4)) { constexpr bool dup = true; (void)dup; {
            {
                Gemm g{LATb, (const bf16_t*)(ws + WS_WUQ), QLORA, 768, QLORA};
                TileOrder S; S.init(NTOK / 256, 6, G, bid, 1);
                EpiQ E{Qb, RQ, rope};
                gemm_phase(lds, g, S, E, g_wave);
            }
            {
                Gemm g{LATb + QLORA, (const bf16_t*)(ws + WS_WK), KVLORA, 768, KVLORA};
                TileOrder S; S.init(NROW / 256, 4, G, bid, 0);
                EpiRowScale E{Kb, 1024, RK};
                gemm_phase(lds, g, S, E, g_wave);
            }
            {
                Gemm g{(const bf16_t*)(ws + WS_WV), LATb + QLORA, KVLORA, KVLORA, 768};
                TileOrder S; S.init(4, NROW / 256, G, bid, 0);
                EpiColScale E{VT, NROW, RK};
                gemm_phase(lds, g, S, E, g_wave);
            }
        } xcd_barrier(xb, MYTID); }
    if (RUN(4)) { constexpr bool dup = false; (void)dup; {
            {
                Gemm g{LATb, (const bf16_t*)(ws + WS_WUQ), QLORA, 768, QLORA};
                TileOrder S; S.init(NTOK / 256, 6, G, bid, 1);
                EpiQ E{Qb, RQ, rope};
                gemm_phase(lds, g, S, E, g_wave);
            }
            {
                Gemm g{LATb + QLORA, (const bf16_t*)(ws + WS_WK), KVLORA, 768, KVLORA};
                TileOrder S; S.init(NROW / 256, 4, G, bid, 0);
                EpiRowScale E{Kb, 1024, RK};
                gemm_phase(lds, g, S, E, g_wave);
            }
            {
                Gemm g{(const bf16_t*)(ws + WS_WV), LATb + QLORA, KVLORA, KVLORA, 768};
                TileOrder S; S.init(4, NROW / 256, G, bid, 0);
                EpiColScale E{VT, NROW, RK};
                gemm_phase(lds, g, S, E, g_wave);
            }
        } }
    SYNC(4);
    if (((DUPSET >> 5) & 1) && RUN(5)) { constexpr bool dup = true; (void)dup; ph_attn(Qb, Kb, KRb, VT, Ob, smem, g_wave); xcd_barrier(xb, MYTID); }
    if (RUN(5)) { constexpr bool dup = false; (void)dup; ph_attn(Qb, Kb, KRb, VT, Ob, smem, g_wave); }
    SYNC(5);
    if (((DUPSET >> 6) & 1) && RUN(6)) { constexpr bool dup = true; (void)dup; {
            Gemm g{Ob, (const bf16_t*)(ws + WS_WO), 1024, 1024, 1024};
            TileOrder S; S.init(NTOK / 256, 4, G, bid, 0);
            EpiResid<true> E{X, p.in[0], modv + 2 * 1024};
            gemm_phase(lds, g, S, E, g_wave);
        } xcd_barrier(xb, MYTID); }
    if (RUN(6)) { constexpr bool dup = false; (void)dup; {
            Gemm g{Ob, (const bf16_t*)(ws + WS_WO), 1024, 1024, 1024};
            TileOrder S; S.init(NTOK / 256, 4, G, bid, 0);
            EpiResid<true> E{X, p.in[0], modv + 2 * 1024};
            gemm_phase(lds, g, S, E, g_wave);
        } }
    SYNC(6);
    if (((DUPSET >> 7) & 1) && RUN(7)) { constexpr bool dup = true; (void)dup; ph_normmod<1>((const float*)X, nullptr, p.in[7], modv, 3, Hb2, g_wave); xcd_barrier(xb, MYTID); }
    if (RUN(7)) { constexpr bool dup = false; (void)dup; ph_normmod<1>((const float*)X, nullptr, p.in[7], modv, 3, Hb2, g_wave); }
    SYNC(7);
    if (((DUPSET >> 8) & 1) && RUN(8)) { constexpr bool dup = true; (void)dup; {
            Gemm g{Hb2, (const bf16_t*)(ws + WS_WQ), 1024, 1024, 1024};
            TileOrder S; S.init(NTOK / 256, 8, G, bid, 0);
            EpiStoreBf16 E{PQ, 2048};
            gemm_phase(lds, g, S, E, g_wave);
        } xcd_barrier(xb, MYTID); }
    if (RUN(8)) { constexpr bool dup = false; (void)dup; {
            Gemm g{Hb2, (const bf16_t*)(ws + WS_WQ), 1024, 1024, 1024};
            TileOrder S; S.init(NTOK / 256, 8, G, bid, 0);
            EpiStoreBf16 E{PQ, 2048};
            gemm_phase(lds, g, S, E, g_wave);
        } }
    SYNC(8);
    if (((DUPSET >> 9) & 1) && RUN(9)) { constexpr bool dup = true; (void)dup; ph_route(PQ, (const bf16_t*)(ws + WS_KEYS), EIDX, GW, smem, g_wave); xcd_barrier(xb, MYTID); }
    if (RUN(9)) { constexpr bool dup = false; (void)dup; ph_route(PQ, (const bf16_t*)(ws + WS_KEYS), EIDX, GW, smem, g_wave); }
    SYNC(9);
    if (((DUPSET >> 10) & 1) && RUN(10)) { constexpr bool dup = true; (void)dup; ph_gather9(Hb2, U8, V8, PSC, PSC + 16384, EIDX, GW, X, dup ? (bf16_t*)PQ : X, modv + 5 * 1024, dup ? nullptr : p.in[6] + 1024, modv1, Hb2, nullptr, smem, g_wave, dup ? nullptr : os + OUT_OB); xcd_barrier(xb, MYTID); }
    if (RUN(10)) { constexpr bool dup = false; (void)dup; ph_gather9(Hb2, U8, V8, PSC, PSC + 16384, EIDX, GW, X, dup ? (bf16_t*)PQ : X, modv + 5 * 1024, dup ? nullptr : p.in[6] + 1024, modv1, Hb2, nullptr, smem, g_wave, dup ? nullptr : os + OUT_OB); }
    SYNC(10);
    if (((DUPSET >> 12) & 1) && RUN(12)) { constexpr bool dup = true; (void)dup; {
            Gemm g{(const bf16_t*)(ws + WS_WIN8), (const bf16_t*)(os + OUT_OB), 512, 512, 512};
            TileOrder S; S.init(12, NTOK / 256, G, bid, 0);
            EpiStoreBf16 E{pT, NTOK};
            gemm_phase<EpiStoreBf16, TileOrder, true>(lds, g, S, E, g_wave);
        } xcd_barrier(xb, MYTID); }
    if (RUN(12)) { constexpr bool dup = false; (void)dup; {
            Gemm g{(const bf16_t*)(ws + WS_WIN8), (const bf16_t*)(os + OUT_OB), 512, 512, 512};
            TileOrder S; S.init(12, NTOK / 256, G, bid, 0);
            EpiStoreBf16 E{pT, NTOK};
            gemm_phase<EpiStoreBf16, TileOrder, true>(lds, g, S, E, g_wave);
        } }
    SYNC(12);
    if (((DUPSET >> 13) & 1) && RUN(13)) { constexpr bool dup = true; (void)dup; ph_conv(p, pT, z2T, smem, g_wave); xcd_barrier(xb, MYTID); }
    if (RUN(13)) { constexpr bool dup = false; (void)dup; ph_conv(p, pT, z2T, smem, g_wave); }
    SYNC(13);
    if (((DUPSET >> 14) & 1) && RUN(14)) { constexpr bool dup = true; (void)dup; ph_transpose(z2T, z2, smem, g_wave); xcd_barrier(xb, MYTID); }
    if (RUN(14)) { constexpr bool dup = false; (void)dup; ph_transpose(z2T, z2, smem, g_wave); }
    SYNC(14);
    if (((DUPSET >> 15) & 1) && RUN(15)) { constexpr bool dup = true; (void)dup; {
            Gemm g{z2, (const bf16_t*)(ws + WS_WOUT), 1024, 1024, 1024};
            TileOrder S; S.init(NTOK / 256, 4, G, bid, 0);
            EpiResid<false> E{dup ? (bf16_t*)(ws + WS_T0 + 128 * MiB) : X, X, modv1 + 2 * 1024};
            gemm_phase(lds, g, S, E, g_wave);
        } xcd_barrier(xb, MYTID); }
    if (RUN(15)) { constexpr bool dup = false; (void)dup; {
            Gemm g{z2, (const bf16_t*)(ws + WS_WOUT), 1024, 1024, 1024};
            TileOrder S; S.init(NTOK / 256, 4, G, bid, 0);
            EpiResid<false> E{dup ? (bf16_t*)(ws + WS_T0 + 128 * MiB) : X, X, modv1 + 2 * 1024};
            gemm_phase(lds, g, S, E, g_wave);
        } }
    SYNC(15);
    if (((DUPSET >> 16) & 1) && RUN(16)) { constexpr bool dup = true; (void)dup; ph_normmod<1>((const float*)X, nullptr, p.in[7] + 1024, modv1, 3, Hb2, g_wave); xcd_barrier(xb, MYTID); }
    if (RUN(16)) { constexpr bool dup = false; (void)dup; ph_normmod<1>((const float*)X, nullptr, p.in[7] + 1024, modv1, 3, Hb2, g_wave); }
    SYNC(16);
    if (((DUPSET >> 17) & 1) && RUN(17)) { constexpr bool dup = true; (void)dup; {
            Gemm g{Hb2, (const bf16_t*)(ws + WS_WQ) + (size_t)2048 * 1024, 1024, 1024, 1024};
            TileOrder S; S.init(NTOK / 256, 8, G, bid, 0);
            EpiStoreBf16 E{PQ, 2048};
            gemm_phase(lds, g, S, E, g_wave);
        } xcd_barrier(xb, MYTID); }
    if (RUN(17)) { constexpr bool dup = false; (void)dup; {
            Gemm g{Hb2, (const bf16_t*)(ws + WS_WQ) + (size_t)2048 * 1024, 1024, 1024, 1024};
            TileOrder S; S.init(NTOK / 256, 8, G, bid, 0);
            EpiStoreBf16 E{PQ, 2048};
            gemm_phase(lds, g, S, E, g_wave);
        } }
    SYNC(17);
    if (((DUPSET >> 18) & 1) && RUN(18)) { constexpr bool dup = true; (void)dup; ph_route(PQ, (const bf16_t*)(ws + WS_KEYS) + (size_t)16 * 128 * 128, EIDX, GW, smem, g_wave); xcd_barrier(xb, MYTID); }
    if (RUN(18)) { constexpr bool dup = false; (void)dup; ph_route(PQ, (const bf16_t*)(ws + WS_KEYS) + (size_t)16 * 128 * 128, EIDX, GW, smem, g_wave); }
    SYNC(18);
    if (((DUPSET >> 19) & 1) && RUN(19)) { constexpr bool dup = true; (void)dup; ph_gather9(Hb2, U8 + 32 * MiB, V8 + 32 * MiB, PSC + 32768, PSC + 32768 + 16384, EIDX, GW, X, dup ? (bf16_t*)PQ : X, modv1 + 5 * 1024, dup ? nullptr : p.in[8], nullptr, nullptr, dup ? nullptr : p.out, smem, g_wave, nullptr); xcd_barrier(xb, MYTID); }
    if (RUN(19)) { constexpr bool dup = false; (void)dup; ph_gather9(Hb2, U8 + 32 * MiB, V8 + 32 * MiB, PSC + 32768, PSC + 32768 + 16384, EIDX, GW, X, dup ? (bf16_t*)PQ : X, modv1 + 5 * 1024, dup ? nullptr : p.in[8], nullptr, nullptr, dup ? nullptr : p.out, smem, g_wave, nullptr); }
}

static inline size_t align_up(size_t v, size_t a) { return (v + a - 1) / a * a; }

extern "C" void kernel_launch(void* const* d_in, const int* in_sizes, int n_in, void* d_out, int out_size, void* d_ws,
                              size_t ws_size, hipStream_t stream) {
    float* out = (float*)d_out;

    static int grid_blocks = 0;
    if (!grid_blocks) {
        int dev = 0, cus = 0, per_cu = 0;
        (void)hipGetDevice(&dev);
        (void)hipDeviceGetAttribute(&cus, hipDeviceAttributeMultiprocessorCount, dev);
        (void)hipOccupancyMaxActiveBlocksPerMultiprocessor(&per_cu, mega, 512, 0);
        if (per_cu > 1) per_cu = 1;
        grid_blocks = cus * per_cu;
        if (grid_blocks != 256) { fprintf(stderr, "mega: built for a 256-workgroup grid, got %d\n", grid_blocks); grid_blocks = -1; }
        if (grid_blocks <= 0) { fprintf(stderr, "mega: occupancy query gave %d blocks/CU on %d CUs\n", per_cu, cus); grid_blocks = -1; }
    }
    if (grid_blocks < 0) return;
    MP p{};
    for (int i = 0; i < 33; ++i) p.in[i] = (const float*)d_in[i];
    p.out = out; p.ws = (unsigned char*)d_ws; p.ph_lo = 0; p.ph_hi = OPT_PHASES;
    (void)hipMemsetAsync((char*)d_ws + WS_CTL, 0, 16 * 1024, stream);
    {
        void* args[] = {&p};
        hipError_t e = hipLaunchCooperativeKernel((void*)mega, dim3(grid_blocks), dim3(512), args, 0, stream);
        if (e != hipSuccess) fprintf(stderr, "cooperative launch failed: %s (grid %d)\n", hipGetErrorString(e), grid_blocks);
    }

}
```
